# Optimizing an MI355X kernel written in HIP

```python
import math
import jax, jax.numpy as jnp
from jax import lax
import numpy as np

D_MODEL = 2048
BATCH = 1
SEQ = 16384
DEPTH = 1
DEC_BATCH = 128
DEC_SEQ = 8
PAST_LEN = 16384
PAGE_SIZE = 128

HEAD_DIM = 128
MIX_WIDTH = D_MODEL
GDN_HEADS = (MIX_WIDTH // 2) // HEAD_DIM
GDN_WIDTH = GDN_HEADS * HEAD_DIM
SWA_HEADS = (MIX_WIDTH - GDN_WIDTH) // HEAD_DIM
SWA_WIDTH = SWA_HEADS * HEAD_DIM
SWA_KV_HEADS = 2
SWA_GROUP = SWA_HEADS // SWA_KV_HEADS
WINDOW = 128
BLOCK = 128
GDN_CONV = 4
GDN_CHUNK = 64
N_META = 16
N_BUCKETS = 32
MAX_DISTANCE = 128
FFN_CONV = 3
D_FF = 11 * D_MODEL // 4
EPS = 1e-6
GDN_QKV_DIM = 3 * GDN_WIDTH
PROJ_SIZES = (GDN_QKV_DIM, GDN_WIDTH, GDN_HEADS, GDN_HEADS, SWA_WIDTH, SWA_KV_HEADS * HEAD_DIM, SWA_KV_HEADS * HEAD_DIM)
PROJ_DIM = sum(PROJ_SIZES)
PROJ_SPLITS = [sum(PROJ_SIZES[:i + 1]) for i in range(len(PROJ_SIZES) - 1)]

kernel_name = "hymba_gdn_swa_sink_convffn_step"


def rmsnorm(x, w):
    x32 = x.astype(jnp.float32)
    y = x32 * lax.rsqrt(jnp.mean(x32 * x32, -1, keepdims=True) + EPS)
    return (y * w.astype(jnp.float32)).astype(x.dtype)


def l2norm(x):
    return x * lax.rsqrt(jnp.sum(x * x, -1, keepdims=True) + EPS)


def causal_dwconv(x, hist, w):
    width, t_len = w.shape[0], x.shape[1]
    xe = jnp.concatenate([hist.astype(x.dtype), x], axis=1)
    return sum(xe[:, i:i + t_len] * w[i].astype(x.dtype) for i in range(width))


def gdn_prepare(qkv, b, a, a_log, dt_bias):
    bsz, t_len, _ = qkv.shape
    q, k, v = jnp.split(qkv.astype(jnp.float32), 3, axis=-1)
    q = l2norm(q.reshape(bsz, t_len, GDN_HEADS, HEAD_DIM)) * HEAD_DIM ** -0.5
    k = l2norm(k.reshape(bsz, t_len, GDN_HEADS, HEAD_DIM))
    v = v.reshape(bsz, t_len, GDN_HEADS, HEAD_DIM)
    beta = jax.nn.sigmoid(b.astype(jnp.float32))
    g = -jnp.exp(a_log.astype(jnp.float32)) * jax.nn.softplus(a.astype(jnp.float32) + dt_bias.astype(jnp.float32))
    return q, k, v, g, beta


def gdn_chunked(q, k, v, g, beta, s0, chunk):
    bsz, t_len, n_h, _ = q.shape
    dv = v.shape[-1]
    n = t_len // chunk

    def blocks(t):
        t = jnp.moveaxis(t, 2, 1)
        return t.reshape(bsz, n_h, n, chunk, *t.shape[3:])

    q, k, v, g, beta = (blocks(t) for t in (q, k, v, g, beta))
    gc = jnp.cumsum(g, axis=-1)
    pos = jnp.arange(chunk)
    causal = pos[:, None] >= pos[None, :]
    strict = pos[:, None] > pos[None, :]
    decay = jnp.exp(jnp.where(causal, gc[..., :, None] - gc[..., None, :], -jnp.inf))
    kb = k * beta[..., None]
    lower = jnp.where(strict, jnp.einsum('bhncd,bhnsd->bhncs', kb, k) * decay, 0.0)
    rhs = jnp.concatenate([v * beta[..., None], kb * jnp.exp(gc)[..., None]], axis=-1)
    sol = lax.linalg.triangular_solve(jnp.eye(chunk, dtype=jnp.float32) + lower, rhs, left_side=True, lower=True)
    u, w = sol[..., :dv], sol[..., dv:]
    qk = jnp.einsum('bhncd,bhnsd->bhncs', q, k) * decay
    qg = q * jnp.exp(gc)[..., None]
    kd = k * jnp.exp(gc[..., -1:] - gc)[..., None]
    gl = jnp.exp(gc[..., -1])

    def step(s, xs):
        u_c, w_c, qk_c, qg_c, kd_c, gl_c = xs
        v_new = u_c - jnp.einsum('bhcd,bhde->bhce', w_c, s)
        o_c = jnp.einsum('bhcd,bhde->bhce', qg_c, s) + jnp.einsum('bhcs,bhse->bhce', qk_c, v_new)
        s = s * gl_c[..., None, None] + jnp.einsum('bhcd,bhce->bhde', kd_c, v_new)
        return s, o_c

    xs = tuple(jnp.moveaxis(t, 2, 0) for t in (u, w, qk, qg, kd, gl))
    s_fin, o = lax.scan(step, s0.astype(jnp.float32), xs)
    o = jnp.moveaxis(o, 0, 2).reshape(bsz, n_h, t_len, dv)
    return jnp.moveaxis(o, 1, 2), s_fin


def gated_rmsnorm(o, z, w):
    bsz, t_len = o.shape[:2]
    zz = z.astype(jnp.float32).reshape(bsz, t_len, GDN_HEADS, HEAD_DIM)
    y = o * lax.rsqrt(jnp.mean(o * o, -1, keepdims=True) + EPS) * w.astype(jnp.float32) * jax.nn.silu(zz)
    return y.reshape(bsz, t_len, GDN_WIDTH)


def t5_bucket(dist):
    n = jnp.maximum(dist, 0)
    exact = N_BUCKETS // 2
    large = exact + (jnp.log(jnp.maximum(n, 1).astype(jnp.float32) / exact)
                     / math.log(MAX_DISTANCE / exact) * (N_BUCKETS - exact)).astype(jnp.int32)
    return jnp.where(n < exact, n, jnp.minimum(large, N_BUCKETS - 1))


def swa_attend(q, k, v, qpos, kpos, is_meta, rel_table, sinks):
    bsz, nblk, nq, n_h, d = q.shape
    ns = k.shape[2]
    qg = q.astype(jnp.float32).reshape(bsz, nblk, nq, SWA_KV_HEADS, SWA_GROUP, d)
    s = jnp.einsum('bnqkgd,bnskd->bnkgqs', qg, k.astype(jnp.float32)) * d ** -0.5
    dist = qpos[:, :, None] - kpos[:, None, :]
    valid = (dist >= 0) & (is_meta[None, None, :] | ((dist < WINDOW) & (kpos[:, None, :] >= N_META)))
    bias = rel_table.astype(jnp.float32)[t5_bucket(dist)]
    bias = bias.reshape(nblk, nq, ns, SWA_KV_HEADS, SWA_GROUP).transpose(0, 3, 4, 1, 2)
    s = jnp.where(valid[:, None, None], s + bias, -jnp.inf)
    sink = sinks.astype(jnp.float32).reshape(SWA_KV_HEADS, SWA_GROUP)[None, None, :, :, None, None]
    m = jnp.maximum(jnp.max(s, -1, keepdims=True), sink)
    p = jnp.exp(s - m)
    p = p / (jnp.sum(p, -1, keepdims=True) + jnp.exp(sink - m))
    o = jnp.einsum('bnkgqs,bnskd->bnqkgd', p, v.astype(jnp.float32))
    return o.reshape(bsz, nblk, nq, n_h * d)


def swa_prompt(q, k, v, rel_table, sinks):
    bsz, seq_len, n_h, d = q.shape
    nb = -(-seq_len // BLOCK)
    lp = nb * BLOCK
    qb = jnp.pad(q, ((0, 0), (0, lp - seq_len), (0, 0), (0, 0))).reshape(bsz, nb, BLOCK, n_h, d)

    def with_meta(t):
        tp = jnp.pad(t, ((0, 0), (BLOCK, lp - seq_len), (0, 0), (0, 0))).reshape(bsz, nb + 1, BLOCK, SWA_KV_HEADS, d)
        band = jnp.concatenate([tp[:, :-1], tp[:, 1:]], axis=2)
        meta = jnp.broadcast_to(t[:, None, :N_META], (bsz, nb, N_META, SWA_KV_HEADS, d))
        return jnp.concatenate([meta, band], axis=2)

    qpos = jnp.arange(lp).reshape(nb, BLOCK)
    band_pos = (jnp.arange(nb)[:, None] - 1) * BLOCK + jnp.arange(2 * BLOCK)[None, :]
    kpos = jnp.concatenate([jnp.broadcast_to(jnp.arange(N_META)[None, :], (nb, N_META)), band_pos], axis=1)
    is_meta = jnp.arange(N_META + 2 * BLOCK) < N_META
    o = swa_attend(qb, with_meta(k), with_meta(v), qpos, kpos, is_meta, rel_table, sinks)
    o = o.reshape(bsz, lp, n_h * d)[:, :seq_len]
    new_meta = jnp.stack([k[:, :N_META], v[:, :N_META]], axis=2)
    new_window = jnp.stack([k[:, seq_len - WINDOW:], v[:, seq_len - WINDOW:]], axis=2)
    return o, (new_meta, new_window)


def swa_sample(q, k, v, meta_kv, window_kv, rel_table, sinks):
    t_len = q.shape[1]
    kv_new = jnp.stack([k, v], axis=2)
    kv_all = jnp.concatenate([meta_kv.astype(kv_new.dtype), window_kv.astype(kv_new.dtype), kv_new], axis=1)
    qpos = (PAST_LEN + jnp.arange(t_len))[None, :]
    kpos = jnp.concatenate([jnp.arange(N_META), PAST_LEN - WINDOW + jnp.arange(WINDOW), PAST_LEN + jnp.arange(t_len)])[None, :]
    is_meta = jnp.arange(N_META + WINDOW + t_len) < N_META
    o = swa_attend(q[:, None], kv_all[:, None, :, 0], kv_all[:, None, :, 1], qpos, kpos, is_meta, rel_table, sinks)
    new_window = jnp.concatenate([window_kv.astype(kv_new.dtype), kv_new], axis=1)[:, -WINDOW:]
    return o[:, 0], (new_window,)


def layer(h, gdn_hist, gdn_s0, ffn_hist, swa_cache, segments, lw, rel_table):
    (w_in, gdn_conv_w, a_log, dt_bias, gdn_norm_w, sinks, w_out,
     n_mix_pre, n_mix_post, n_ffn_pre, n_ffn_post, w_gate, w_up, ffn_conv_w, w_down) = lw
    bsz, t_len, _ = h.shape
    xn = rmsnorm(h, n_mix_pre)
    qkv_raw, z, b, a, sq, sk, sv = jnp.split(xn @ w_in, PROJ_SPLITS, axis=-1)
    qkv = jax.nn.silu(causal_dwconv(qkv_raw, gdn_hist, gdn_conv_w))
    q, k, v, g, beta = gdn_prepare(qkv, b, a, a_log, dt_bias)
    s = gdn_s0
    outs = []
    start = 0
    for length, chunk in segments:
        sl = slice(start, start + length)
        o_seg, s = gdn_chunked(q[:, sl], k[:, sl], v[:, sl], g[:, sl], beta[:, sl], s, chunk)
        outs.append(o_seg)
        start += length
    gdn_out = gated_rmsnorm(jnp.concatenate(outs, axis=1), z, gdn_norm_w).astype(h.dtype)
    new_gdn_conv = jnp.concatenate([gdn_hist.astype(qkv_raw.dtype), qkv_raw], axis=1)[:, -(GDN_CONV - 1):]
    sq = sq.reshape(bsz, t_len, SWA_HEADS, HEAD_DIM)
    sk = sk.reshape(bsz, t_len, SWA_KV_HEADS, HEAD_DIM)
    sv = sv.reshape(bsz, t_len, SWA_KV_HEADS, HEAD_DIM)
    if swa_cache is None:
        swa_out, swa_new = swa_prompt(sq, sk, sv, rel_table, sinks)
    else:
        swa_out, swa_new = swa_sample(sq, sk, sv, swa_cache[0], swa_cache[1], rel_table, sinks)
    mix = jnp.concatenate([gdn_out, swa_out.astype(h.dtype)], axis=-1) @ w_out
    h = h + rmsnorm(mix, n_mix_post)
    xn = rmsnorm(h, n_ffn_pre)
    gate_raw = xn @ w_gate
    gate = causal_dwconv(gate_raw, ffn_hist, ffn_conv_w)
    y = (jax.nn.silu(gate) * (xn @ w_up)) @ w_down
    h = h + rmsnorm(y, n_ffn_post)
    new_ffn_conv = jnp.concatenate([ffn_hist.astype(gate_raw.dtype), gate_raw], axis=1)[:, -(FFN_CONV - 1):]
    return h, swa_new, new_gdn_conv, s.astype(gdn_s0.dtype), new_ffn_conv


def setup_inputs(seed: int = 0) -> dict:
    key = jax.random.key(seed)
    ks = jax.random.split(key, 24)
    f32 = jnp.float32
    nrm = lambda k_, shape, scale=1.0: jax.random.normal(k_, shape, f32) * scale
    dt = jnp.exp(jax.random.uniform(ks[11], (DEPTH, GDN_HEADS), f32, math.log(1e-3), math.log(1e-1)))
    return {
        'x_prompt': nrm(ks[0], (BATCH, SEQ, D_MODEL)),
        'x_sample': nrm(ks[1], (DEC_BATCH, DEC_SEQ, D_MODEL)),
        'cache_swa_meta_kv': nrm(ks[2], (DEPTH, DEC_BATCH, N_META, 2, SWA_KV_HEADS, HEAD_DIM)),
        'cache_swa_window_kv': nrm(ks[3], (DEPTH, DEC_BATCH, WINDOW, 2, SWA_KV_HEADS, HEAD_DIM)),
        'state_gdn_conv': nrm(ks[4], (DEPTH, DEC_BATCH, GDN_CONV - 1, GDN_QKV_DIM)),
        'state_gdn': nrm(ks[5], (DEPTH, DEC_BATCH, GDN_HEADS, HEAD_DIM, HEAD_DIM), HEAD_DIM ** -0.5),
        'state_ffn_conv': nrm(ks[6], (DEPTH, DEC_BATCH, FFN_CONV - 1, D_FF)),
        'meta_tokens': nrm(ks[7], (N_META, D_MODEL)),
        'rel_bias_table': nrm(ks[8], (N_BUCKETS, SWA_HEADS), 0.5),
        'w_in': nrm(ks[9], (DEPTH, D_MODEL, PROJ_DIM), D_MODEL ** -0.5),
        'gdn_conv_w': nrm(ks[10], (DEPTH, GDN_CONV, GDN_QKV_DIM), GDN_CONV ** -0.5),
        'gdn_a_log': jnp.log(jax.random.uniform(ks[12], (DEPTH, GDN_HEADS), f32, 1.0, 16.0)),
        'gdn_dt_bias': dt + jnp.log(-jnp.expm1(-dt)),
        'gdn_norm_w': 1.0 + nrm(ks[13], (DEPTH, HEAD_DIM), 0.01),
        'swa_sinks': nrm(ks[14], (DEPTH, SWA_HEADS)),
        'w_out': nrm(ks[15], (DEPTH, MIX_WIDTH, D_MODEL), MIX_WIDTH ** -0.5),
        'norm_mix_pre': 1.0 + nrm(ks[16], (DEPTH, D_MODEL), 0.01),
        'norm_mix_post': 1.0 + nrm(ks[17], (DEPTH, D_MODEL), 0.01),
        'norm_ffn_pre': 1.0 + nrm(ks[18], (DEPTH, D_MODEL), 0.01),
        'norm_ffn_post': 1.0 + nrm(ks[19], (DEPTH, D_MODEL), 0.01),
        'ffn_w_gate': nrm(ks[20], (DEPTH, D_MODEL, D_FF), D_MODEL ** -0.5),
        'ffn_w_up': nrm(ks[21], (DEPTH, D_MODEL, D_FF), D_MODEL ** -0.5),
        'ffn_conv_w': nrm(ks[22], (DEPTH, FFN_CONV, D_FF), FFN_CONV ** -0.5),
        'ffn_w_down': nrm(ks[23], (DEPTH, D_FF, D_MODEL), D_FF ** -0.5),
    }


def reference(x_prompt, x_sample, cache_swa_meta_kv, cache_swa_window_kv, state_gdn_conv, state_gdn, state_ffn_conv,
              meta_tokens, rel_bias_table, w_in, gdn_conv_w, gdn_a_log, gdn_dt_bias, gdn_norm_w, swa_sinks, w_out,
              norm_mix_pre, norm_mix_post, norm_ffn_pre, norm_ffn_post, ffn_w_gate, ffn_w_up, ffn_conv_w, ffn_w_down):
    bsz = x_prompt.shape[0]
    hp = jnp.concatenate([jnp.broadcast_to(meta_tokens.astype(x_prompt.dtype)[None], (bsz, N_META, D_MODEL)), x_prompt], axis=1)
    hs = x_sample
    prompt_segments = ((N_META, N_META), (x_prompt.shape[1], GDN_CHUNK))
    sample_segments = ((x_sample.shape[1], x_sample.shape[1]),)
    p_states, s_states = [], []
    for l in range(DEPTH):
        lw = (w_in[l], gdn_conv_w[l], gdn_a_log[l], gdn_dt_bias[l], gdn_norm_w[l], swa_sinks[l], w_out[l],
              norm_mix_pre[l], norm_mix_post[l], norm_ffn_pre[l], norm_ffn_post[l],
              ffn_w_gate[l], ffn_w_up[l], ffn_conv_w[l], ffn_w_down[l])
        hp, p_swa, p_gc, p_gs, p_fc = layer(
            hp, jnp.zeros((bsz, GDN_CONV - 1, GDN_QKV_DIM), hp.dtype),
            jnp.zeros((bsz, GDN_HEADS, HEAD_DIM, HEAD_DIM), hp.dtype),
            jnp.zeros((bsz, FFN_CONV - 1, D_FF), hp.dtype), None, prompt_segments, lw, rel_bias_table)
        hs, s_swa, s_gc, s_gs, s_fc = layer(
            hs, state_gdn_conv[l], state_gdn[l], state_ffn_conv[l],
            (cache_swa_meta_kv[l], cache_swa_window_kv[l]), sample_segments, lw, rel_bias_table)
        p_states.append((p_swa[0], p_swa[1], p_gc, p_gs, p_fc))
        s_states.append((s_swa[0], s_gc, s_gs, s_fc))
    p_meta_kv, p_window_kv, p_gdn_conv, p_gdn_state, p_ffn_conv = [jnp.stack(t) for t in zip(*p_states)]
    s_window_kv, s_gdn_conv, s_gdn_state, s_ffn_conv = [jnp.stack(t) for t in zip(*s_states)]
    y_prompt = hp[:, N_META:]
    return (y_prompt, hs, p_meta_kv, p_window_kv, p_gdn_conv, p_gdn_state, p_ffn_conv,
            s_window_kv, s_gdn_conv, s_gdn_state, s_ffn_conv)
```

```cpp
#include <hip/hip_runtime.h>
#include <cstdio>
#include <cstdint>

namespace pg8 {
#define PG8_LAS __attribute__((address_space(3)))
typedef unsigned short bf16_t;
typedef short bf16x8 __attribute__((ext_vector_type(8)));
typedef float f32x4 __attribute__((ext_vector_type(4)));
typedef unsigned u32x4 __attribute__((ext_vector_type(4)));
constexpr int BM = 256, BK = 64, HALF = 128, HTB = HALF * BK * 2  , STAGE_BYTES = 8 * HTB, NXCD = 8, WGM = 4;

__host__ __device__ __forceinline__ int lds_byte(int r, int c) { const int st = (r >> 4) * 2 + (c >> 5), rr = r & 15, cc = c & 31, ob = rr * 64 + cc * 2; return st * 1024 + (ob ^ (((ob >> 9) & 1) << 5)); }
__host__ __device__ __forceinline__ void stage_rc(int b, int& R, int& C) { const int st = b / 1024, sb = b % 1024, swz = sb ^ (((sb >> 9) & 1) << 5); R = (st >> 1) * 16 + swz / 64; C = (st & 1) * 32 + (swz % 64) / 2; }
__host__ __device__ __forceinline__ int perm32(int rho) { const int n = rho >> 4, i = rho & 15; return 8 * (i >> 2) + 4 * n + (i & 3); }

struct Unit { int pm, pn, kt0, nk, sp; };
struct Gemm { const bf16_t* A; const bf16_t* Bt; int nM, nN, K; };

struct StaticOrder {
    int nM, nN, nwg, G, c, ktiles, nMt, nsp;
    __host__ __device__ void init(int nM_, int nN_, int G_, int c_, int ktiles_, int nMt_ = 0, int nsp_ = 1) { nM = nM_; nN = nN_; nwg = nM * nN; G = G_; c = c_; ktiles = ktiles_; nMt = nMt_; nsp = nsp_; }
    __host__ __device__ __forceinline__ bool next(int i, Unit& u) const {
        const long L = (long)i * G + c;
        const bool tail = L >= nwg;
        const int Lt = (int)(L - nwg), nt_ = nMt * nN;
        if (tail && Lt >= nt_ * nsp) return false;
        int wgid = tail ? 0 : (int)L; { const int q = nwg / NXCD, r = nwg % NXCD, xcd = wgid % NXCD, off = wgid / NXCD; wgid = (xcd < r ? xcd * (q + 1) : r * (q + 1) + (xcd - r) * q) + off; }
        const int nig = WGM * nN, gid = wgid / nig, fm = gid * WGM, gsz = (nM - fm) < WGM ? (nM - fm) : WGM;
        const int sp = tail ? Lt / (nt_ > 0 ? nt_ : 1) : -1, w = tail ? Lt % (nt_ > 0 ? nt_ : 1) : 0;
        const int prs = ktiles / 2, qs = prs / nsp, rs = prs % nsp, spc = sp < 0 ? 0 : sp;
        const int nks = 2 * (qs + (spc < rs ? 1 : 0)), kts = 2 * (spc * qs + (spc < rs ? spc : rs));
        Unit r_;
        r_.pm = tail ? nM + w / nN : fm + ((wgid % nig) % gsz);
        r_.pn = tail ? w % nN : (wgid % nig) / gsz;
        r_.kt0 = tail ? kts : 0; r_.nk = tail ? nks : ktiles; r_.sp = sp;
        u = r_; return true;
    }
};

struct AMapStd {
    static constexpr int HSTEP_ROWS = 128;
    static __host__ __device__ __forceinline__ int row_in_half(int R) { return R; }
    static __host__ __device__ __forceinline__ long base_row(int pm) { return (long)pm * 256; }
};

__device__ __forceinline__ unsigned cvt_pk_bf16(float lo, float hi) { unsigned r; asm volatile("v_cvt_pk_bf16_f32 %0, %1, %2" : "=v"(r) : "v"(lo), "v"(hi)); return r; }

template <class Epi, class AM, bool ALIGN_EPI = true>
__device__ __forceinline__ void gemm_phase(PG8_LAS unsigned char* lds, const Gemm g, const StaticOrder& S, const Epi& E) {
    const int tid = threadIdx.x, wid = __builtin_amdgcn_readfirstlane(tid >> 6), lane = tid & 63, wr = wid >> 2, wc = wid & 3, fr = lane & 15, fq = lane >> 4;
    const int K = g.K;
    unsigned voffA[2], voffB[2];
#pragma unroll
    for (int i = 0; i < 2; ++i) { int R, C; stage_rc(tid * 16 + i * 8192, R, C); const int Rb = Epi::PERM ? ((R & ~31) + perm32(R & 31)) : R;
        voffA[i] = (unsigned)(AM::row_in_half(R) * K + C) * 2u; voffB[i] = (unsigned)(Rb * K + C) * 2u; }
    const size_t kstep = (size_t)(BK * 2);
    const size_t hstepB = (size_t)HALF * K * 2;
    const size_t hstepA = (size_t)AM::HSTEP_ROWS * K * 2;
    const size_t tstepB = 2 * hstepB;
    const size_t rowb = (size_t)K * 2;
    const unsigned ldsw = (unsigned)wid * 1024u;
    const int aoff = lds_byte(wr * 64 + fr, fq * 8), boff = lds_byte(wc * 32 + fr, fq * 8);
#define PG8_SA(b, h) (((b) * 2 + (h)) * HTB)
#define PG8_SB(b, h) ((4 + (b) * 2 + (h)) * HTB)
#define PG8_STAGE(bufoff, gbase, voff) do { _Pragma("unroll") for (int _i = 0; _i < 2; ++_i) \
        __builtin_amdgcn_global_load_lds((const unsigned*)((const char*)(gbase) + (voff)[_i]), (PG8_LAS unsigned*)(lds + (bufoff) + ldsw + _i * 8192), 16, 0, 0); } while (0)
#define PG8_LDA(dst, b, h) do { _Pragma("unroll") for (int m = 0; m < 4; ++m) _Pragma("unroll") for (int k = 0; k < 2; ++k) dst[m][k] = *(const PG8_LAS bf16x8*)(lds + PG8_SA(b, h) + aoff + m * 2048 + k * 1024); } while (0)
#define PG8_LDB(dst, b, h) do { _Pragma("unroll") for (int n = 0; n < 2; ++n) _Pragma("unroll") for (int k = 0; k < 2; ++k) dst[n][k] = *(const PG8_LAS bf16x8*)(lds + PG8_SB(b, h) + boff + n * 2048 + k * 1024); } while (0)
#define PG8_MMA(ai, bj, At, Bt) do { __builtin_amdgcn_s_setprio(1); _Pragma("unroll") for (int m = 0; m < 4; ++m) _Pragma("unroll") for (int n = 0; n < 2; ++n) _Pragma("unroll") for (int k = 0; k < 2; ++k) \
        acc[ai][bj][m][n] = __builtin_amdgcn_mfma_f32_16x16x32_bf16(Bt[n][k], At[m][k], acc[ai][bj][m][n], 0, 0, 0); __builtin_amdgcn_s_setprio(0); } while (0)
#define PG8_WAIT_V(n) asm volatile("s_waitcnt vmcnt(" #n ")" ::: "memory")
#define PG8_WAIT_L(n) asm volatile("s_waitcnt lgkmcnt(" #n ")" ::: "memory")
#define PG8_BAR __builtin_amdgcn_s_barrier()
#define PG8_SCHED __builtin_amdgcn_sched_barrier(0)
    Unit cur, nxt; int ui = 0;
    if (!S.next(0, cur)) return;
    f32x4 acc[2][2][4][2];
#pragma unroll
    for (int a = 0; a < 2; ++a)
#pragma unroll
        for (int b = 0; b < 2; ++b)
#pragma unroll
            for (int m = 0; m < 4; ++m)
#pragma unroll
                for (int n = 0; n < 2; ++n) acc[a][b][m][n] = (f32x4){0.f, 0.f, 0.f, 0.f};
    bf16x8 At[4][2], B0[2][2], B1[2][2];
    const char* cA = (const char*)g.A + (size_t)AM::base_row(cur.pm) * rowb + (size_t)cur.kt0 * kstep; const char* cB = (const char*)g.Bt + (size_t)cur.pn * tstepB + (size_t)cur.kt0 * kstep;
    PG8_STAGE(PG8_SB(0, 0), cB, voffB); PG8_STAGE(PG8_SB(0, 1), cB + hstepB, voffB); PG8_STAGE(PG8_SA(0, 0), cA, voffA); PG8_STAGE(PG8_SA(0, 1), cA + hstepA, voffA);
    if (wr == 1) PG8_BAR;
    PG8_WAIT_V(2); PG8_BAR;
    PG8_STAGE(PG8_SB(1, 0), cB + kstep, voffB); PG8_STAGE(PG8_SA(1, 0), cA + kstep, voffA); PG8_STAGE(PG8_SB(1, 1), cB + hstepB + kstep, voffB);
    PG8_WAIT_V(6); PG8_BAR;
    for (;;) {
        const bool has_next = S.next(ui + 1, nxt);
        const char* nA = has_next ? (const char*)g.A + (size_t)AM::base_row(nxt.pm) * rowb + (size_t)nxt.kt0 * kstep : cA; const char* nB = has_next ? (const char*)g.Bt + (size_t)nxt.pn * tstepB + (size_t)nxt.kt0 * kstep : cB;
        const int nt = cur.nk;
        for (int t = 0; t < nt; t += 2) {
            const bool last = (t == nt - 2);
            const char* a1 = cA + (size_t)(t + 1) * kstep;
            const char* a2 = last ? nA : cA + (size_t)(t + 2) * kstep; const char* b2 = last ? nB : cB + (size_t)(t + 2) * kstep;
            const char* a3 = a2 + kstep; const char* b3 = b2 + kstep;
            PG8_LDB(B0, 0, 0); PG8_LDB(B1, 0, 1); PG8_SCHED; PG8_LDA(At, 0, 0); PG8_STAGE(PG8_SA(1, 1), a1 + hstepA, voffA);
            PG8_WAIT_V(8); PG8_WAIT_L(0); PG8_BAR; PG8_MMA(0, 0, At, B0); PG8_MMA(0, 1, At, B1); PG8_BAR; PG8_SCHED;
            PG8_LDA(At, 0, 1); PG8_STAGE(PG8_SB(0, 0), b2, voffB); PG8_STAGE(PG8_SB(0, 1), b2 + hstepB, voffB); PG8_STAGE(PG8_SA(0, 0), a2, voffA);
            PG8_WAIT_V(8); PG8_WAIT_L(0); PG8_BAR; PG8_MMA(1, 0, At, B0); PG8_MMA(1, 1, At, B1); PG8_BAR; PG8_SCHED;
            PG8_LDB(B0, 1, 0); PG8_LDB(B1, 1, 1); PG8_SCHED; PG8_LDA(At, 1, 0); PG8_STAGE(PG8_SA(0, 1), a2 + hstepA, voffA);
            PG8_WAIT_V(8); PG8_WAIT_L(0); PG8_BAR; PG8_MMA(0, 0, At, B0); PG8_MMA(0, 1, At, B1); PG8_BAR; PG8_SCHED;
            PG8_LDA(At, 1, 1); PG8_STAGE(PG8_SB(1, 0), b3, voffB); PG8_STAGE(PG8_SB(1, 1), b3 + hstepB, voffB); PG8_STAGE(PG8_SA(1, 0), a3, voffA);
            PG8_WAIT_V(8); PG8_WAIT_L(0); PG8_BAR; PG8_MMA(1, 0, At, B0); PG8_MMA(1, 1, At, B1); PG8_BAR; PG8_SCHED;
        }
        if constexpr (ALIGN_EPI) { if (wr == 0) PG8_BAR; }
        E(acc, cur, wr, wc, fr, fq);
        if (!has_next) break;
#pragma unroll
        for (int a = 0; a < 2; ++a)
#pragma unroll
            for (int b = 0; b < 2; ++b)
#pragma unroll
                for (int m = 0; m < 4; ++m)
#pragma unroll
                    for (int n = 0; n < 2; ++n) acc[a][b][m][n] = (f32x4){0.f, 0.f, 0.f, 0.f};
        cur = nxt; cA = nA; cB = nB; ++ui;
        if constexpr (ALIGN_EPI) { if (wr == 1) PG8_BAR; }
    }
    PG8_WAIT_V(0);
    if constexpr (!ALIGN_EPI) { if (wr == 0) PG8_BAR; }
    PG8_BAR;
#undef PG8_SA
#undef PG8_SB
#undef PG8_STAGE
#undef PG8_LDA
#undef PG8_LDB
#undef PG8_MMA
#undef PG8_WAIT_V
#undef PG8_WAIT_L
#undef PG8_BAR
#undef PG8_SCHED
}
}

constexpr int NWAVES = 8, NTHR = 512;
constexpr int DM = 2048, NMETA = 16, SEQ = 16384, NPOS = NMETA + SEQ  , DBATCH = 128, DSEQ = 8, NSAMP = DBATCH * DSEQ;
constexpr int ROW_S = 16448;
constexpr int MPAD = 17664;
constexpr int HD = 128, NH = 8, KVH = 2, GW = 1024, QKVD = 3072, DFF = 5632, NCH = 257, CH = 64;
constexpr int PAST = 16384, WIN = 128;
constexpr float EPS = 1e-6f;
constexpr int NPROJ = 5632, SQKV_LD = 1536;

constexpr size_t O_YP = 0, O_YS = O_YP + (size_t)SEQ * DM, O_PMETA = O_YS + (size_t)NSAMP * DM, O_PWIN = O_PMETA + 16 * 2 * 2 * 128, O_PGC = O_PWIN + 128 * 2 * 2 * 128,
                 O_PGS = O_PGC + 3 * QKVD, O_PFC = O_PGS + (size_t)NH * HD * HD, O_SWIN = O_PFC + 2 * DFF, O_SGC = O_SWIN + (size_t)DBATCH * 128 * 512, O_SGS = O_SGC + (size_t)DBATCH * 3 * QKVD,
                 O_SFC = O_SGS + (size_t)DBATCH * NH * HD * HD, O_END = O_SFC + (size_t)DBATCH * 2 * DFF;

constexpr size_t MiB = 1u << 20;
constexpr size_t WS_CTL = 0, CTL_ZERO_BYTES = 64 * 1024;
constexpr size_t WS_BA = 1 * MiB;
constexpr size_t WS_GL = 3 * MiB;
constexpr size_t WS_WIN = 4 * MiB;
constexpr size_t WS_WBA = 27 * MiB;
constexpr size_t WS_WOUT = 28 * MiB;
constexpr size_t WS_XN = 36 * MiB;
constexpr size_t WS_VT = 106 * MiB;
constexpr int VT_LD = 16512;
constexpr size_t WS_QKV = 116 * MiB;
constexpr size_t WS_Z = 220 * MiB;
constexpr size_t WS_SQKV = 255 * MiB;
constexpr size_t WS_SCANIN = 307 * MiB;
constexpr size_t SCANIN_ITEM = 73728, SI_W = 0, SI_KD = 16384, SI_U = 32768, SI_QG = 49152, SI_QK = 65536;
constexpr size_t WS_SCANOUT = WS_QKV;
constexpr size_t SCANOUT_ITEM = 49152;
constexpr size_t WS_WGU = 452 * MiB;
constexpr size_t WS_WDOWN = 4 * MiB;
constexpr size_t WS_MIXOUT = 116 * MiB;
constexpr size_t WS_ACT = 255 * MiB;
constexpr size_t WS_PART = 186 * MiB;
constexpr int TAIL_ROW0 = 16384, TAIL_ROWS = 1280, NSPLIT = 4;
constexpr size_t WS_END = 496 * MiB;
static_assert(WS_WIN + (size_t)NPROJ * DM * 2 <= WS_WBA && WS_WOUT + (size_t)DM * DM * 2 <= WS_XN && WS_XN + (size_t)MPAD * DM * 2 <= WS_VT, "ws map 1");
static_assert(WS_VT + (size_t)2 * 128 * VT_LD * 2 <= WS_QKV && WS_QKV + (size_t)MPAD * QKVD * 2 <= WS_Z && WS_Z + (size_t)MPAD * 1024 * 2 <= WS_SQKV, "ws map 2");
static_assert(WS_SQKV + (size_t)MPAD * SQKV_LD * 2 <= WS_SCANIN && WS_SCANIN + (size_t)NH * NCH * SCANIN_ITEM <= WS_WGU, "ws map 3");
static_assert(WS_SCANOUT + (size_t)NH * NCH * SCANOUT_ITEM <= WS_Z, "ws map 4");
static_assert(WS_WGU + (size_t)2 * DFF * DM * 2 <= WS_END && WS_WDOWN + (size_t)DM * DFF * 2 <= WS_WBA && WS_MIXOUT + (size_t)MPAD * DM * 2 <= WS_Z && WS_ACT + (size_t)MPAD * DFF * 2 <= WS_WGU && WS_END <= 512 * MiB, "ws map 5");
constexpr int CW_BAR = 1024;

constexpr int RING_BYTES = 131072;
constexpr int MISC_OFF = 147456 - 256;
constexpr int XCH_OFF = RING_BYTES;
constexpr int LDS_BYTES = 147456;

#define GAS __attribute__((address_space(1)))
#define LAS __attribute__((address_space(3)))
typedef unsigned short bf16;
typedef unsigned v4u __attribute__((ext_vector_type(4)));
typedef unsigned v2u __attribute__((ext_vector_type(2)));
typedef float f32x4 __attribute__((ext_vector_type(4)));
typedef float f32x16 __attribute__((ext_vector_type(16)));
typedef short bf16x8 __attribute__((ext_vector_type(8)));
typedef GAS unsigned gu32;
#define RLX_AGENT __ATOMIC_RELAXED, __HIP_MEMORY_SCOPE_AGENT
#define DI __device__ __forceinline__
typedef float f32x2_ __attribute__((ext_vector_type(2)));
typedef __bf16 bf16x2_ __attribute__((ext_vector_type(2)));
DI unsigned pk2(float lo, float hi) { const f32x2_ v = {lo, hi}; return __builtin_bit_cast(unsigned, __builtin_convertvector(v, bf16x2_)); }
DI unsigned f2bf(float f) { return pk2(f, 0.f) & 0xffffu; }
DI float bf2f(unsigned short b) { return __builtin_bit_cast(float, (unsigned)b << 16); }
DI float bflo(unsigned w) { return __builtin_bit_cast(float, w << 16); }
DI float bfhi(unsigned w) { return __builtin_bit_cast(float, w & 0xffff0000u); }
#define LDS_SYNC() do { asm volatile("s_waitcnt lgkmcnt(0)" ::: "memory"); __builtin_amdgcn_s_barrier(); asm volatile("" ::: "memory"); } while (0)
DI float wave_sum(float v) {
#pragma unroll
    for (int o = 1; o < 64; o <<= 1) v += __shfl_xor(v, o);
    return v;
}
DI float sigmoidf_(float x) { return __builtin_amdgcn_rcpf(1.f + __expf(-x)); }
DI float siluf_(float x) { return x * __builtin_amdgcn_rcpf(1.f + __expf(-x)); }
DI float softplusf_(float x) { return x > 20.f ? x : log1pf(__expf(x)); }
DI f32x4 mfma16(bf16x8 a, bf16x8 b, f32x4 c) { return __builtin_amdgcn_mfma_f32_16x16x32_bf16(a, b, c, 0, 0, 0); }
DI f32x16 mfma32(bf16x8 a, bf16x8 b, f32x16 c) { return __builtin_amdgcn_mfma_f32_32x32x16_bf16(a, b, c, 0, 0, 0); }
DI bf16x8 pack8(float a0, float a1, float a2, float a3, float a4, float a5, float a6, float a7) {
    v4u p; p.x = pk2(a0, a1); p.y = pk2(a2, a3); p.z = pk2(a4, a5); p.w = pk2(a6, a7); return __builtin_bit_cast(bf16x8, p);
}

#define XB_TMO      128
#define XB_XCNT(j)  (256  + 64 * (j))
#define XB_XSUB(j)  (1280 + 64 * (j))
#define XB_XGEN(j)  (2304 + 64 * (j))
#define XB_TOP      3328
#define XB_TOPGEN   3392
#define XCD_BAR_WORDS 3456
#define XB_SPIN_CAP (1u << 18)
DI unsigned xb_ld(unsigned* p)              { return __hip_atomic_load(p, __ATOMIC_RELAXED, __HIP_MEMORY_SCOPE_AGENT); }
DI unsigned xb_add(unsigned* p, unsigned v) { return __hip_atomic_fetch_add(p, v, __ATOMIC_RELAXED, __HIP_MEMORY_SCOPE_AGENT); }
DI unsigned xb_xcc_id() { return (unsigned)__builtin_amdgcn_s_getreg((3 << 11) | 20) & 0xFu; }
#define XB_SPIN(cond, bar) do { unsigned _sp = 0; while (cond) { __builtin_amdgcn_s_sleep(1); \
    if ((++_sp & 255u) == 0u) { if (xb_ld(&(bar)[XB_TMO])) break; if (_sp > XB_SPIN_CAP) { atomicAdd(&(bar)[XB_TMO], 1u); break; } } } } while (0)
struct XcdBarrier { unsigned* bar; unsigned x; volatile LAS unsigned* st; };
DI XcdBarrier xcd_barrier_post(unsigned* bar, volatile LAS unsigned* st) {
    XcdBarrier b; b.bar = bar; b.x = xb_xcc_id(); b.st = st;
    if (threadIdx.x == 0) (void)xb_add(&bar[XB_XCNT(b.x)], 1u);
    return b;
}
DI void xcd_barrier_complete(unsigned* bar, unsigned x, unsigned& nloc, unsigned& nx) {
    const unsigned G = gridDim.x * gridDim.y * gridDim.z;
    unsigned sum, cnt, mine, sp = 0u;
    for (;;) {
        sum = 0u; cnt = 0u; mine = 0u;
#pragma unroll
        for (unsigned j = 0; j < 16; ++j) { const unsigned c = xb_ld(&bar[XB_XCNT(j)]); sum += c; cnt += (c > 0u) ? 1u : 0u; mine = (j == x) ? c : mine; }
        if (sum == G) break;
        __builtin_amdgcn_s_sleep(1);
        if ((++sp & 255u) == 0u) { if (xb_ld(&bar[XB_TMO])) break; if (sp > XB_SPIN_CAP) { atomicAdd(&bar[XB_TMO], 1u); break; } }
    }
    nloc = mine > 0u ? mine : 1u; nx = cnt > 0u ? cnt : 1u;
}
DI void xcd_barrier(const XcdBarrier& b) {
    asm volatile("s_waitcnt vmcnt(0)" ::: "memory");
    __syncthreads();
    if (threadIdx.x == 0) {
        unsigned* bar = b.bar;
        __builtin_amdgcn_s_waitcnt(0);
        unsigned nloc = b.st[0], nx = b.st[1];
        if (nloc == 0u) { xcd_barrier_complete(bar, b.x, nloc, nx); b.st[0] = nloc; b.st[1] = nx; }
        const unsigned old = xb_add(&bar[XB_XSUB(b.x)], 1u);
        const unsigned gen = old / nloc;
        if (old + 1u == (gen + 1u) * nloc) {
            __builtin_amdgcn_fence(__ATOMIC_RELEASE, "agent");
            asm volatile("s_waitcnt vmcnt(0)" ::: "memory");
            const unsigned og = xb_add(&bar[XB_TOP], 1u);
            const unsigned tg = og / nx;
            if (og + 1u == (tg + 1u) * nx) xb_add(&bar[XB_TOPGEN], 1u);
            else XB_SPIN(xb_ld(&bar[XB_TOPGEN]) == tg, bar);
            __builtin_amdgcn_fence(__ATOMIC_ACQUIRE, "agent");
            xb_add(&bar[XB_XGEN(b.x)], 1u);
            asm volatile("s_waitcnt vmcnt(0)" ::: "memory");
        } else {
            XB_SPIN(xb_ld(&bar[XB_XGEN(b.x)]) == gen, bar);
            __builtin_amdgcn_fence(__ATOMIC_ACQUIRE, "agent");
            asm volatile("s_waitcnt vmcnt(0)" ::: "memory");
        }
    }
    __syncthreads();
}

struct Args { const float* in[24]; float* out; unsigned char* ws; int ph_lo, ph_hi, sub, pad; };
struct Frame {
    LAS unsigned char* lds;
    int tid, lane, wave, G, bid;
    const float* const* in;
};

DI void transpose_item(const float* W, int src_ld, int src_col0, int k0, bf16* WT, int dst_ld, int dst_row0, LAS float* scr, int lane) {
#pragma unroll 8
    for (int i = 0; i < 32; ++i) { const int kk = 2 * i + (lane >> 5); scr[kk * 33 + (lane & 31)] = W[(size_t)(k0 + kk) * src_ld + src_col0 + (lane & 31)]; }
    asm volatile("s_waitcnt lgkmcnt(0)" ::: "memory");
    const int c = lane & 7;
#pragma unroll
    for (int j = 0; j < 4; ++j) { const int n = (lane >> 3) + 8 * j; const LAS float* s = scr + (8 * c) * 33 + n;
        v4u o; o.x = pk2(s[0 * 33], s[1 * 33]); o.y = pk2(s[2 * 33], s[3 * 33]); o.z = pk2(s[4 * 33], s[5 * 33]); o.w = pk2(s[6 * 33], s[7 * 33]);
        *(GAS v4u*)(WT + (size_t)(dst_row0 + n) * dst_ld + k0 + 8 * c) = o; }
    asm volatile("s_waitcnt lgkmcnt(0)" ::: "memory");
}
DI void rms_row_to_bf16(const float* xrow, const f32x4 (&wv)[8], bf16* orow, int lane) {
    GAS unsigned long long* o8 = (GAS unsigned long long*)orow + lane;
    if (!xrow) {
#pragma unroll
        for (int j = 0; j < 8; ++j) o8[64 * j] = 0ull;
        return; }
    const GAS f32x4* xr = (const GAS f32x4*)xrow + lane;
    f32x4 v[8]; float s = 0.f;
#pragma unroll
    for (int j = 0; j < 8; ++j) { v[j] = xr[64 * j]; s += (v[j].x * v[j].x + v[j].y * v[j].y) + (v[j].z * v[j].z + v[j].w * v[j].w); }
    const float rstd = 1.f / sqrtf(wave_sum(s) * (1.f / DM) + EPS);
#pragma unroll
    for (int j = 0; j < 8; ++j) { const f32x4 ww = wv[j];
        o8[64 * j] = (unsigned long long)pk2(v[j].x * rstd * ww.x, v[j].y * rstd * ww.y) | ((unsigned long long)pk2(v[j].z * rstd * ww.z, v[j].w * rstd * ww.w) << 32); }
}
DI const float* x_row(const Args& a, int r) {
    if (r < NMETA) return a.in[7] + (size_t)r * DM;
    if (r < NPOS) return a.in[0] + (size_t)(r - NMETA) * DM;
    if (r < ROW_S) return nullptr;
    if (r < ROW_S + NSAMP) return a.in[1] + (size_t)(r - ROW_S) * DM;
    return nullptr;
}
DI void p0_prologue(const Args& a, LAS unsigned char* lds, int gw, int NGW, int lane, int wave) {
    LAS float* scr = (LAS float*)(lds + wave * 16384);
    bf16* WIN = (bf16*)(a.ws + WS_WIN); bf16* WOUT = (bf16*)(a.ws + WS_WOUT); bf16* WBA = (bf16*)(a.ws + WS_WBA); bf16* XN = (bf16*)(a.ws + WS_XN);
    constexpr int I_IN = 32 * (NPROJ / 32), I_OUT = 32 * (DM / 32);
    for (int it = gw; it < I_IN + I_OUT; it += NGW) {
        if (it < I_IN) { const int kb = it / (NPROJ / 32), nb = it % (NPROJ / 32); const int n0 = 32 * nb;
            transpose_item(a.in[9], 5648, n0 + (n0 >= 4096 ? 16 : 0), 64 * kb, WIN, DM, n0, scr, lane); }
        else { const int r = it - I_IN; const int kb = r / (DM / 32), nb = r % (DM / 32); transpose_item(a.in[15], DM, 32 * nb, 64 * kb, WOUT, DM, 32 * nb, scr, lane); }
    }
    for (int e = gw * 64 + lane; e < 16 * DM; e += NGW * 64) { const int n = e / DM, k = e % DM; WBA[e] = (bf16)f2bf(a.in[9][(size_t)k * 5648 + 4096 + n]); }
    f32x4 wv[8];
#pragma unroll
    for (int j = 0; j < 8; ++j) wv[j] = ((const GAS f32x4*)a.in[16])[lane + 64 * j];
    for (int m = gw; m < MPAD; m += NGW) rms_row_to_bf16(x_row(a, m), wv, XN + (size_t)m * DM, lane);
}
DI void p5_ffn_weights(const Args& a, LAS unsigned char* lds, int gw, int NGW, int lane, int wave, int part) {
    LAS float* scr = (LAS float*)(lds + wave * 16384);
    bf16* WGU = (bf16*)(a.ws + WS_WGU); bf16* WDOWN = (bf16*)(a.ws + WS_WDOWN);
    constexpr int I_GU = 32 * (2 * DFF / 32), I_DN = (DFF / 64) * (DM / 32);
    for (int it = (part ? I_GU : 0) + gw; it < (part ? I_GU + I_DN : I_GU); it += NGW) {
        if (it < I_GU) { const int kb = it / (2 * DFF / 32), nb = it % (2 * DFF / 32); const int u = nb >> 3, bi = nb & 7;
            const float* src = bi < 4 ? a.in[20] : a.in[21];
            transpose_item(src, DFF, 128 * u + 32 * (bi & 3), 64 * kb, WGU, DM, 32 * nb, scr, lane); }
        else { const int r = it - I_GU; const int kb = r / (DM / 32), nb = r % (DM / 32); transpose_item(a.in[23], DM, 32 * nb, 64 * kb, WDOWN, DFF, 32 * nb, scr, lane); }
    }
}
constexpr int BA_RS = 4112, BA_AS = 528, BA_AOFF = 16 * BA_RS, BA_ABUF = 64 * BA_AS, BA_RED = BA_AOFF + 2 * BA_ABUF;
DI void p1_ba(const Args& a, LAS unsigned char* lds, int bid, int G, int tid, int lane, int wave) {
    const bf16* XN = (const bf16*)(a.ws + WS_XN); const bf16* WBA = (const bf16*)(a.ws + WS_WBA); float* BA = (float*)(a.ws + WS_BA);
    for (int e = tid; e < 16 * 256; e += NTHR) *(LAS v4u*)(lds + (e >> 8) * BA_RS + (e & 255) * 16) = *(const GAS v4u*)(WBA + (size_t)(e >> 8) * DM + (e & 255) * 8);
    const int r = lane & 15, q = lane >> 4, rs = wave & 3, kh = wave >> 2;
    for (int it = bid; it < MPAD / 64; it += G) {
        const bf16* A0 = XN + (size_t)64 * it * DM;
        v4u st[4][4];
#pragma unroll
        for (int c = 0; c < 4; ++c)
#pragma unroll
            for (int j = 0; j < 4; ++j) { const int e = tid + 512 * j; st[c][j] = *(const GAS v4u*)(A0 + (size_t)(e >> 5) * DM + 256 * c + (e & 31) * 8); }
        f32x4 acc = {0.f, 0.f, 0.f, 0.f};
#pragma unroll
        for (int c = 0; c < 8; ++c) {
#pragma unroll
            for (int j = 0; j < 4; ++j) { const int e = tid + 512 * j; *(LAS v4u*)(lds + BA_AOFF + (c & 1) * BA_ABUF + (e >> 5) * BA_AS + (e & 31) * 16) = st[c & 3][j]; }
            if (c + 4 < 8) {
#pragma unroll
                for (int j = 0; j < 4; ++j) { const int e = tid + 512 * j; st[c & 3][j] = *(const GAS v4u*)(A0 + (size_t)(e >> 5) * DM + 256 * (c + 4) + (e & 31) * 8); }
            }
            LDS_SYNC();
            const LAS unsigned char* ab = lds + BA_AOFF + (c & 1) * BA_ABUF + (16 * rs + r) * BA_AS + 16 * q + 256 * kh;
            const LAS unsigned char* bb = lds + r * BA_RS + 512 * c + 16 * q + 256 * kh;
#pragma unroll
            for (int s = 0; s < 4; ++s) acc = mfma16(*(const LAS bf16x8*)(ab + 64 * s), *(const LAS bf16x8*)(bb + 64 * s), acc);
        }
        LDS_SYNC();
        LAS f32x4* red = (LAS f32x4*)(lds + BA_RED);
        if (kh == 1) red[rs * 64 + lane] = acc;
        LDS_SYNC();
        if (kh == 0) { acc += red[rs * 64 + lane];
#pragma unroll
            for (int i = 0; i < 4; ++i) BA[(size_t)(64 * it + 16 * rs + 4 * q + i) * 16 + r] = acc[i]; }
        LDS_SYNC();
    }
}

struct EpiProj {
    static constexpr bool PERM = true;
    bf16* qkv; bf16* z; bf16* sqkv;
    DI void operator()(const f32x4 (&acc)[2][2][4][2], const pg8::Unit& u, int wr, int wc, int fr, int fq) const {
        bf16* base; int ldc, colt;
        if (u.pn < 12) { base = qkv; ldc = QKVD; colt = u.pn * 256; } else if (u.pn < 16) { base = z; ldc = 1024; colt = (u.pn - 12) * 256; } else { base = sqkv; ldc = SQKV_LD; colt = (u.pn - 16) * 256; }
        const int row0 = u.pm * 256 + wr * 64 + fr, col0 = colt + wc * 32 + 8 * fq;
#pragma unroll
        for (int ai = 0; ai < 2; ++ai)
#pragma unroll
            for (int m = 0; m < 4; ++m) { bf16* rowp = base + (size_t)(row0 + ai * 128 + m * 16) * ldc + col0;
#pragma unroll
                for (int bj = 0; bj < 2; ++bj) { const f32x4 v0 = acc[ai][bj][m][0], v1 = acc[ai][bj][m][1];
                    v4u w; w.x = pg8::cvt_pk_bf16(v0[0], v0[1]); w.y = pg8::cvt_pk_bf16(v0[2], v0[3]); w.z = pg8::cvt_pk_bf16(v1[0], v1[1]); w.w = pg8::cvt_pk_bf16(v1[2], v1[3]);
                    *(v4u*)(rowp + bj * 128) = w; } }
    }
};
struct EpiSplit {
    static constexpr bool PERM = true;
    bf16* O; int ldc; float* P; int row0, prow;
    DI void operator()(const f32x4 (&acc)[2][2][4][2], const pg8::Unit& u, int wr, int wc, int fr, int fq) const {
        const int rowb = u.pm * 256 + wr * 64 + fr, col0 = u.pn * 256 + wc * 32 + 8 * fq;
#pragma unroll
        for (int ai = 0; ai < 2; ++ai)
#pragma unroll
            for (int m = 0; m < 4; ++m) { const int row = rowb + ai * 128 + m * 16;
#pragma unroll
                for (int bj = 0; bj < 2; ++bj) { const f32x4 v0 = acc[ai][bj][m][0], v1 = acc[ai][bj][m][1];
                    if (u.sp < 0) { v4u w; w.x = pg8::cvt_pk_bf16(v0[0], v0[1]); w.y = pg8::cvt_pk_bf16(v0[2], v0[3]); w.z = pg8::cvt_pk_bf16(v1[0], v1[1]); w.w = pg8::cvt_pk_bf16(v1[2], v1[3]);
                        *(v4u*)(O + (size_t)row * ldc + col0 + bj * 128) = w; }
                    else { float* pp = P + ((size_t)u.sp * prow + (row - row0)) * ldc + col0 + bj * 128; *(f32x4*)pp = v0; *(f32x4*)(pp + 4) = v1; } } }
    }
};
struct EpiPlain {
    static constexpr bool PERM = true;
    bf16* O; int ldc;
    DI void operator()(const f32x4 (&acc)[2][2][4][2], const pg8::Unit& u, int wr, int wc, int fr, int fq) const {
        const int row0 = u.pm * 256 + wr * 64 + fr, col0 = u.pn * 256 + wc * 32 + 8 * fq;
#pragma unroll
        for (int ai = 0; ai < 2; ++ai)
#pragma unroll
            for (int m = 0; m < 4; ++m) { bf16* rowp = O + (size_t)(row0 + ai * 128 + m * 16) * ldc + col0;
#pragma unroll
                for (int bj = 0; bj < 2; ++bj) { const f32x4 v0 = acc[ai][bj][m][0], v1 = acc[ai][bj][m][1];
                    v4u w; w.x = pg8::cvt_pk_bf16(v0[0], v0[1]); w.y = pg8::cvt_pk_bf16(v0[2], v0[3]); w.z = pg8::cvt_pk_bf16(v1[0], v1[1]); w.w = pg8::cvt_pk_bf16(v1[2], v1[3]);
                    *(v4u*)(rowp + bj * 128) = w; } }
    }
};

constexpr int FFN_PT = 65, FFN_NM = 69;
struct AMapFfn {
    static constexpr int HSTEP_ROWS = 4;
    static __host__ __device__ __forceinline__ int row_in_half(int R) { return 128 * ((R >> 6) & 1) + 8 * (R & 15) + ((R >> 4) & 3); }
    static __host__ __device__ __forceinline__ long base_row(int pm) { return pm < FFN_PT ? (long)(NMETA + 254 * pm - 2) : (long)(ROW_S + 256 * (pm - FFN_PT)); }
};
struct EpiFfn {
    static constexpr bool PERM = true;
    bf16* act; const float* cw; const float* hist; float* out; LAS float* xch;
    DI void operator()(const f32x4 (&acc)[2][2][4][2], const pg8::Unit& u, int wr, int wc, int fr, int fq) const {
        const bool samp = u.pm >= FFN_PT;
        const int rho = 16 * wr + fr, colb = 128 * u.pn + 32 * wc + 8 * fq;
        const long row0 = AMapFfn::base_row(u.pm) + 8 * rho;
        if (wr == 0 && fr == 15) {
#pragma unroll
            for (int n = 0; n < 2; ++n)
#pragma unroll
                for (int e = 0; e < 4; ++e) { xch[(wc * 2 + 0) * 32 + 8 * fq + 4 * n + e] = acc[1][0][2][n][e]; xch[(wc * 2 + 1) * 32 + 8 * fq + 4 * n + e] = acc[1][0][3][n][e]; }
        }
        asm volatile("s_waitcnt lgkmcnt(0)" ::: "memory"); __builtin_amdgcn_s_barrier(); asm volatile("" ::: "memory");
        unsigned res[8][4]; float aprev[8];
        const bool tailt = !samp && u.pm == FFN_PT - 1;
        const int sb_ = 32 * (u.pm - FFN_PT) + rho;
#pragma unroll
        for (int n = 0; n < 2; ++n) {
            const int col4 = colb + 4 * n;
            const f32x4 w0v = *(const f32x4*)(cw + col4), w1v = *(const f32x4*)(cw + DFF + col4), w2v = *(const f32x4*)(cw + 2 * DFF + col4);
            f32x4 h0v = {0.f, 0.f, 0.f, 0.f}, h1v = {0.f, 0.f, 0.f, 0.f};
            if (samp) { h0v = *(const f32x4*)(hist + (size_t)(sb_ * 2 + 0) * DFF + col4); h1v = *(const f32x4*)(hist + (size_t)(sb_ * 2 + 1) * DFF + col4); }
            f32x4 g6v, g7v;
#pragma unroll
            for (int e = 0; e < 4; ++e) {
                const int col = col4 + e;
                const float w0 = w0v[e], w1 = w1v[e], w2 = w2v[e];
                float g[8], up[8];
#pragma unroll
                for (int j = 0; j < 8; ++j) { g[j] = acc[j >> 2][0][j & 3][n][e]; up[j] = acc[j >> 2][1][j & 3][n][e]; }
                float pm1 = __shfl_up(g[7], 1), pm2 = __shfl_up(g[6], 1);
                if (samp) { pm2 = h0v[e]; pm1 = h1v[e]; }
                else if (fr == 0) { if (wr == 1) { pm2 = xch[(wc * 2 + 0) * 32 + 8 * fq + 4 * n + e]; pm1 = xch[(wc * 2 + 1) * 32 + 8 * fq + 4 * n + e]; } else { pm1 = 0.f; pm2 = 0.f; } }
#pragma unroll
                for (int j = 0; j < 8; ++j) {
                    const float gm1 = j >= 1 ? g[j - 1] : pm1, gm2 = j >= 2 ? g[j - 2] : (j == 1 ? pm1 : pm2);
                    const float c = w0 * gm2 + w1 * gm1 + w2 * g[j];
                    const float a = siluf_(c) * up[j];
                    if ((e & 1) == 0) aprev[j] = a; else res[j][2 * n + (e >> 1)] = pk2(aprev[j], a);
                }
                g6v[e] = g[6]; g7v[e] = g[7];
                if (tailt) {
#pragma unroll
                    for (int j = 0; j < 8; ++j) { const long r = row0 + j; if (r == NPOS - 2) out[O_PFC + col] = g[j]; if (r == NPOS - 1) out[O_PFC + DFF + col] = g[j]; }
                }
            }
            if (samp) { *(f32x4*)(out + O_SFC + (size_t)(sb_ * 2 + 0) * DFF + col4) = g6v; *(f32x4*)(out + O_SFC + (size_t)(sb_ * 2 + 1) * DFF + col4) = g7v; }
        }
#pragma unroll
        for (int j = 0; j < 8; ++j) {
            const long r = row0 + j; const bool ok = samp ? true : ((8 * rho + j >= 2) && r < NPOS);
            if (ok) { v4u w; w.x = res[j][0]; w.y = res[j][1]; w.z = res[j][2]; w.w = res[j][3]; *(v4u*)(act + (size_t)r * DFF + colb) = w; }
        }
    }
};

DI float sumsq8(const f32x4 (&v)[8]) { float s = 0.f;
#pragma unroll
    for (int j = 0; j < 8; ++j) s += (v[j].x * v[j].x + v[j].y * v[j].y) + (v[j].z * v[j].z + v[j].w * v[j].w);
    return s; }
DI f32x4 bf4(v2u w) { return (f32x4){bflo(w.x), bfhi(w.x), bflo(w.y), bfhi(w.y)}; }
struct Row6 { f32x4 x[8]; v2u m[8]; };
DI void row6_load(Row6& r, const Args& a, int m, int lane) {
    const GAS f32x4* xr = (const GAS f32x4*)x_row(a, m) + lane; const GAS v2u* mr = (const GAS v2u*)((const bf16*)(a.ws + WS_MIXOUT) + (size_t)m * DM) + lane;
#pragma unroll
    for (int j = 0; j < 8; ++j) { r.x[j] = xr[64 * j]; r.m[j] = mr[64 * j]; }
}
DI void row6_finish(const f32x4 (&mv)[8], const f32x4 (&xv)[8], const f32x4 (&wp)[8], const f32x4 (&wf)[8], bf16* xn2row, bf16* h1row, int lane) {
    const float rstd = __builtin_amdgcn_rsqf(wave_sum(sumsq8(mv)) * (1.f / DM) + EPS);
    f32x4 hv[8];
#pragma unroll
    for (int j = 0; j < 8; ++j) hv[j] = xv[j] + mv[j] * rstd * wp[j];
    const float rstd2 = __builtin_amdgcn_rsqf(wave_sum(sumsq8(hv)) * (1.f / DM) + EPS);
    GAS v2u* h8 = (GAS v2u*)h1row + lane;
#pragma unroll
    for (int j = 0; j < 8; ++j) h8[64 * j] = (v2u){pk2(hv[j].x, hv[j].y), pk2(hv[j].z, hv[j].w)};
    GAS unsigned long long* o8 = (GAS unsigned long long*)xn2row + lane;
#pragma unroll
    for (int j = 0; j < 8; ++j) { const f32x4 ww = wf[j];
        o8[64 * j] = (unsigned long long)pk2(hv[j].x * rstd2 * ww.x, hv[j].y * rstd2 * ww.y) | ((unsigned long long)pk2(hv[j].z * rstd2 * ww.z, hv[j].w * rstd2 * ww.w) << 32); }
}
DI void p6_rows(const Args& a, int gw, int NGW, int lane) {
    bf16* XN2 = (bf16*)(a.ws + WS_XN); bf16* MO = (bf16*)(a.ws + WS_MIXOUT);
    f32x4 wp[8], wf[8];
#pragma unroll
    for (int j = 0; j < 8; ++j) { wp[j] = ((const GAS f32x4*)a.in[17])[lane + 64 * j]; wf[j] = ((const GAS f32x4*)a.in[18])[lane + 64 * j]; }
    {
        Row6 A, B; int m = gw;
        if (m < TAIL_ROW0) row6_load(A, a, m, lane);
        for (; m < TAIL_ROW0; m += 2 * NGW) {
            const int m1 = m + NGW, m2 = m + 2 * NGW;
            if (m1 < TAIL_ROW0) row6_load(B, a, m1, lane);
            { f32x4 mv[8];
#pragma unroll
              for (int j = 0; j < 8; ++j) mv[j] = bf4(A.m[j]);
              row6_finish(mv, A.x, wp, wf, XN2 + (size_t)m * DM, MO + (size_t)m * DM, lane); }
            if (m1 >= TAIL_ROW0) break;
            if (m2 < TAIL_ROW0) row6_load(A, a, m2, lane);
            { f32x4 mv[8];
#pragma unroll
              for (int j = 0; j < 8; ++j) mv[j] = bf4(B.m[j]);
              row6_finish(mv, B.x, wp, wf, XN2 + (size_t)m1 * DM, MO + (size_t)m1 * DM, lane); }
        }
    }
    for (int m = TAIL_ROW0 + gw; m < MPAD; m += NGW) {
        const float* xrow = x_row(a, m);
        if (!xrow) { GAS unsigned long long* o8 = (GAS unsigned long long*)(XN2 + (size_t)m * DM) + lane;
#pragma unroll
            for (int j = 0; j < 8; ++j) o8[64 * j] = 0ull;
            continue; }
        const GAS f32x4* xr = (const GAS f32x4*)xrow + lane;
        const GAS f32x4* pr = (const GAS f32x4*)((const float*)(a.ws + WS_PART) + (size_t)(m - TAIL_ROW0) * DM) + lane;
        f32x4 mv[8], xv[8];
#pragma unroll
        for (int j = 0; j < 8; ++j) { xv[j] = xr[64 * j]; mv[j] = pr[64 * j]; }
#pragma unroll 1
        for (int sp = 1; sp < NSPLIT; ++sp) {
#pragma unroll
            for (int j = 0; j < 8; ++j) mv[j] += pr[(size_t)sp * TAIL_ROWS * (DM / 4) + 64 * j]; }
        row6_finish(mv, xv, wp, wf, XN2 + (size_t)m * DM, MO + (size_t)m * DM, lane);
    }
}
struct Row9 { v2u h[8], y[8]; };
DI void row9_load(Row9& r, const Args& a, int i, int lane) {
    const GAS v2u* hr = (const GAS v2u*)((const bf16*)(a.ws + WS_MIXOUT) + (size_t)(NMETA + i) * DM) + lane; const GAS v2u* yr = (const GAS v2u*)((const bf16*)(a.ws + WS_XN) + (size_t)(NMETA + i) * DM) + lane;
#pragma unroll
    for (int j = 0; j < 8; ++j) { r.h[j] = hr[64 * j]; r.y[j] = yr[64 * j]; }
}
DI void row9_finish(const v2u (&hp)[8], const f32x4 (&yv)[8], const f32x4 (&wq)[8], float* orow, int lane) {
    const float rstd2 = __builtin_amdgcn_rsqf(wave_sum(sumsq8(yv)) * (1.f / DM) + EPS);
    GAS f32x4* o4 = (GAS f32x4*)orow + lane;
#pragma unroll
    for (int j = 0; j < 8; ++j) o4[64 * j] = bf4(hp[j]) + yv[j] * rstd2 * wq[j];
}
DI void p9_rows(const Args& a, LAS unsigned char* lds, int tid, int gw, int NGW, int lane) {
    f32x4 wq[8];
#pragma unroll
    for (int j = 0; j < 8; ++j) wq[j] = ((const GAS f32x4*)a.in[19])[lane + 64 * j];
    constexpr int NMAIN = TAIL_ROW0 - NMETA;
    {
        Row9 A, B; int i = gw;
        if (i < NMAIN) row9_load(A, a, i, lane);
        for (; i < NMAIN; i += 2 * NGW) {
            const int i1 = i + NGW, i2 = i + 2 * NGW;
            if (i1 < NMAIN) row9_load(B, a, i1, lane);
            { f32x4 yv[8];
#pragma unroll
              for (int j = 0; j < 8; ++j) yv[j] = bf4(A.y[j]);
              row9_finish(A.h, yv, wq, a.out + O_YP + (size_t)i * DM, lane); }
            if (i1 >= NMAIN) break;
            if (i2 < NMAIN) row9_load(A, a, i2, lane);
            { f32x4 yv[8];
#pragma unroll
              for (int j = 0; j < 8; ++j) yv[j] = bf4(B.y[j]);
              row9_finish(B.h, yv, wq, a.out + O_YP + (size_t)i1 * DM, lane); }
        }
    }
    const bf16* MO = (const bf16*)(a.ws + WS_MIXOUT);
    for (int i = NMAIN + gw; i < SEQ + NSAMP; i += NGW) {
        const int m = i < SEQ ? NMETA + i : ROW_S + (i - SEQ);
        float* orow = i < SEQ ? a.out + O_YP + (size_t)i * DM : a.out + O_YS + (size_t)(i - SEQ) * DM;
        const GAS v2u* hr = (const GAS v2u*)(MO + (size_t)m * DM) + lane;
        const GAS f32x4* pr = (const GAS f32x4*)((const float*)(a.ws + WS_PART) + (size_t)(m - TAIL_ROW0) * DM) + lane;
        v2u hp[8]; f32x4 yv[8];
#pragma unroll
        for (int j = 0; j < 8; ++j) { hp[j] = hr[64 * j]; yv[j] = pr[64 * j]; }
#pragma unroll 1
        for (int sp = 1; sp < NSPLIT; ++sp) {
#pragma unroll
            for (int j = 0; j < 8; ++j) yv[j] += pr[(size_t)sp * TAIL_ROWS * (DM / 4) + 64 * j]; }
        row9_finish(hp, yv, wq, orow, lane);
    }
}

constexpr int L_KN = 0, L_QN = 17408, L_KB = 34816, L_VBT = 52224, L_KBGT = 70656, L_KDT = 89088, L_AM = 107520, L_TL = 124928, L_GC = 134144, L_RED = 134656  ;
constexpr int RS = 136;
constexpr int TS = 72;
constexpr int AS = 68;
constexpr int RAWS = 392;
DI int perm64(int t) { return (t & 32) + 8 * ((t >> 2) & 3) + 4 * ((t >> 4) & 1) + (t & 3); }
DI float wave_incl_scan(float v, int lane) {
#pragma unroll
    for (int o = 1; o < 64; o <<= 1) { const float n = __shfl_up(v, o); if (lane >= o) v += n; }
    return v;
}
struct PrepIn { v4u rv[7]; float wv[3]; float bb, aa; };
DI void prep_fetch(PrepIn& p, const Args& a, int item, int tid, int lane) {
    const int h = item / NCH, c = item % NCH, r0 = CH * c;
    const bf16* QKV = (const bf16*)(a.ws + WS_QKV); const float* BA = (const float*)(a.ws + WS_BA);
    const int cc = tid % 48, rb = tid / 48;
    const bf16* gsrc = QKV + (long)(r0 - 3 + rb) * QKVD + (cc >> 4) * GW + h * HD + (cc & 15) * 8;
#pragma unroll
    for (int i = 0; i < 7; ++i) { p.rv[i] = (v4u){0u, 0u, 0u, 0u};
        if (tid < 480 && rb + 10 * i < 67 && r0 - 3 + rb + 10 * i >= 0) p.rv[i] = *(const GAS v4u*)(gsrc + (long)(10 * i) * QKVD); }
#pragma unroll
    for (int i = 0; i < 3; ++i) { const int e = tid + 512 * i, tap = e / 384, ch = e % 384; p.wv[i] = a.in[10][(size_t)tap * QKVD + (ch >> 7) * GW + h * HD + (ch & 127)]; }
    const int row = r0 + lane; p.bb = 0.f; p.aa = 0.f;
    if (row < NPOS) { p.bb = BA[(size_t)row * 16 + h]; p.aa = BA[(size_t)row * 16 + 8 + h]; }
}
DI void gdn_prep_item(const Args& a, LAS unsigned char* lds, int item, int next_item, PrepIn& pin, int tid_in, int lane_in, int wave) {
    int tid = tid_in, lane = lane_in; asm volatile("" : "+v"(tid), "+v"(lane));
    const int h = item / NCH, c = item % NCH, r0 = CH * c;
    const bf16* QKV = (const bf16*)(a.ws + WS_QKV); const float* BA = (const float*)(a.ws + WS_BA);
    const bool dry = (a.sub & 512) != 0; const int stop = (a.sub >> 10) & 15;
    unsigned char* si = dry ? a.ws + 500 * MiB : a.ws + WS_SCANIN + (size_t)item * SCANIN_ITEM;
    LAS bf16* KN = (LAS bf16*)(lds + L_KN); LAS bf16* QN = (LAS bf16*)(lds + L_QN); LAS bf16* KB = (LAS bf16*)(lds + L_KB);
    LAS bf16* VBT = (LAS bf16*)(lds + L_VBT); LAS bf16* KBGT = (LAS bf16*)(lds + L_KBGT); LAS bf16* KDT = (LAS bf16*)(lds + L_KDT);
    LAS float* AM = (LAS float*)(lds + L_AM); LAS bf16* TL = (LAS bf16*)(lds + L_TL); LAS float* GC = (LAS float*)(lds + L_GC); LAS float* RED = (LAS float*)(lds + L_RED);
    const int t = lane, row = r0 + t; const bool valid = row < NPOS;
    float beta = 0.f, g = 0.f;
    if (valid) { beta = sigmoidf_(pin.bb); g = -__expf(a.in[11][h]) * softplusf_(pin.aa + a.in[12][h]); }
    const float gc = wave_incl_scan(g, lane);
    const float gcl = __shfl(gc, 63);
    if (wave == 0) { GC[t] = gc; if (lane == 0 && !dry) ((float*)(a.ws + WS_GL))[item] = __expf(gcl); }
    {
        LAS bf16* RAW = (LAS bf16*)lds; LAS float* WCV = (LAS float*)(lds + L_AM);
        const int cc = tid % 48, rb = tid / 48;
#pragma unroll
        for (int i = 0; i < 7; ++i) { if (tid < 480 && rb + 10 * i < 67) *(LAS v4u*)(RAW + (rb + 10 * i) * RAWS + cc * 8) = pin.rv[i]; }
#pragma unroll
        for (int i = 0; i < 3; ++i) WCV[tid + 512 * i] = pin.wv[i];
    }
    if (next_item >= 0) prep_fetch(pin, a, next_item, tid, lane);
    LDS_SYNC();
    if (dry && stop == 1) return;
    float qv[16], kv[16], vv[16];
    {
        const LAS bf16* RAW = (const LAS bf16*)lds; const LAS float* WCV = (const LAS float*)(lds + L_AM);
        const int d0 = 16 * wave;
#pragma unroll
        for (int part = 0; part < 3; ++part) {
            float acc[16];
#pragma unroll
            for (int j = 0; j < 16; ++j) acc[j] = 0.f;
#pragma unroll 2
            for (int i = 0; i < 4; ++i) {
                const v4u x0 = *(const LAS v4u*)(RAW + (t + i) * RAWS + part * 128 + d0), x1 = *(const LAS v4u*)(RAW + (t + i) * RAWS + part * 128 + d0 + 8);
                const LAS f32x4* w4 = (const LAS f32x4*)(WCV + i * 384 + part * 128 + d0);
                const f32x4 wa = w4[0], wb = w4[1], wc = w4[2], wd = w4[3];
                const float w[16] = {wa[0], wa[1], wa[2], wa[3], wb[0], wb[1], wb[2], wb[3], wc[0], wc[1], wc[2], wc[3], wd[0], wd[1], wd[2], wd[3]};
                const unsigned xs[8] = {x0.x, x0.y, x0.z, x0.w, x1.x, x1.y, x1.z, x1.w};
#pragma unroll
                for (int j = 0; j < 8; ++j) { acc[2 * j] += w[2 * j] * bflo(xs[j]); acc[2 * j + 1] += w[2 * j + 1] * bfhi(xs[j]); }
            }
#pragma unroll
            for (int j = 0; j < 16; ++j) { const float s = siluf_(acc[j]); if (part == 0) qv[j] = s; else if (part == 1) kv[j] = s; else vv[j] = s; }
        }
        float sq = 0.f, sk = 0.f;
#pragma unroll
        for (int j = 0; j < 16; ++j) { sq += qv[j] * qv[j]; sk += kv[j] * kv[j]; }
        RED[wave * 64 + t] = sq; RED[512 + wave * 64 + t] = sk;
    }
    LDS_SYNC();
    if (dry && stop == 2) return;
    {
        float sq = 0.f, sk = 0.f;
#pragma unroll
        for (int w = 0; w < 8; ++w) { sq += RED[w * 64 + t]; sk += RED[512 + w * 64 + t]; }
        const float rq = 1.f / sqrtf(sq + EPS) * 0.08838834764831845f, rk = 1.f / sqrtf(sk + EPS);
        const float eg = __expf(gc), ekd = __expf(gcl - gc);
        const int d0 = 16 * wave, pt = perm64(t);
        unsigned wq[8], wk[8], wb[8];
#pragma unroll
        for (int j = 0; j < 8; ++j) { const float k0 = kv[2 * j] * rk, k1 = kv[2 * j + 1] * rk;
            wq[j] = pk2(qv[2 * j] * rq, qv[2 * j + 1] * rq); wk[j] = pk2(k0, k1); wb[j] = pk2(k0 * beta, k1 * beta); }
        *(LAS v4u*)(QN + t * RS + d0) = (v4u){wq[0], wq[1], wq[2], wq[3]}; *(LAS v4u*)(QN + t * RS + d0 + 8) = (v4u){wq[4], wq[5], wq[6], wq[7]};
        *(LAS v4u*)(KN + t * RS + d0) = (v4u){wk[0], wk[1], wk[2], wk[3]}; *(LAS v4u*)(KN + t * RS + d0 + 8) = (v4u){wk[4], wk[5], wk[6], wk[7]};
        *(LAS v4u*)(KB + t * RS + d0) = (v4u){wb[0], wb[1], wb[2], wb[3]}; *(LAS v4u*)(KB + t * RS + d0 + 8) = (v4u){wb[4], wb[5], wb[6], wb[7]};
#pragma unroll
        for (int j = 0; j < 16; ++j) { const float kn = kv[j] * rk;
            VBT[(d0 + j) * TS + t] = (bf16)f2bf(vv[j] * beta); KBGT[(d0 + j) * TS + t] = (bf16)f2bf(kn * beta * eg); KDT[(d0 + j) * TS + pt] = (bf16)f2bf(kn * ekd); }
    }
    LDS_SYNC();
    if (dry && stop == 3) return;
    const int r = lane & 15, q = lane >> 4;
    {
        int tmt[3], tnt[3]; bool isl[3]; f32x4 acc[3]; bf16x8 af[3][4], bfr[3][4];
#pragma unroll
        for (int k = 0; k < 3; ++k) {
            const int idx = (wave + 8 * k < 20) ? wave + 8 * k : wave; isl[k] = idx < 10;
            int a_ = 0, b_ = isl[k] ? idx : idx - 10; while (b_ >= a_ + 1) { b_ -= a_ + 1; ++a_; }
            tmt[k] = isl[k] ? a_ : b_; tnt[k] = isl[k] ? b_ : a_;
            const LAS bf16* pa = (isl[k] ? KB : KN) + (16 * tmt[k] + r) * RS + 8 * q; const LAS bf16* pb = (isl[k] ? KN : QN) + (16 * tnt[k] + r) * RS + 8 * q;
#pragma unroll
            for (int s = 0; s < 4; ++s) { af[k][s] = *(const LAS bf16x8*)(pa + 32 * s); bfr[k][s] = *(const LAS bf16x8*)(pb + 32 * s); }
            acc[k] = (f32x4){0.f, 0.f, 0.f, 0.f};
        }
#pragma unroll
        for (int s = 0; s < 4; ++s)
#pragma unroll
            for (int k = 0; k < 3; ++k) acc[k] = mfma16(af[k][s], bfr[k][s], acc[k]);
#pragma unroll
        for (int k = 0; k < 3; ++k) {
            if (k == 2 && wave >= 4) break;
            const int cn = 16 * tnt[k] + r; const float gn = GC[cn];
            if (isl[k]) {
#pragma unroll
                for (int e = 0; e < 4; ++e) { const int i = 16 * tmt[k] + 4 * q + e; AM[i * AS + cn] = i > cn ? acc[k][e] * __expf(GC[i] - gn) : 0.f; }
            } else {
                float o[4];
#pragma unroll
                for (int e = 0; e < 4; ++e) { const int ck = 16 * tmt[k] + 4 * q + e; o[e] = cn >= ck ? acc[k][e] * __expf(gn - GC[ck]) : 0.f; }
                *(GAS v2u*)((bf16*)(si + SI_QK) + cn * 64 + 32 * (tmt[k] >> 1) + 8 * q + 4 * (tmt[k] & 1)) = (v2u){pk2(o[0], o[1]), pk2(o[2], o[3])};
            }
        }
        if (wave >= 4) {
            for (int z = wave - 4; z < 6; z += 4) {
                const int mt = z == 0 ? 1 : (z < 3 ? 2 : 3), nt = z == 0 ? 0 : (z < 3 ? z - 1 : z - 3);
                *(GAS v2u*)((bf16*)(si + SI_QK) + (16 * nt + r) * 64 + 32 * (mt >> 1) + 8 * q + 4 * (mt & 1)) = (v2u){0u, 0u};
            }
        }
    }
    LDS_SYNC();
    if (dry && stop == 4) return;
    LAS float* TF = (LAS float*)(lds + L_KN); LAS float* XF = (LAS float*)(lds + L_KB);
    if (wave < 3) {
        const int e = wave * 64 + lane, n = e & 15, p = (e >> 4) - 4;
        const bool diag = e < 64, act = e < 160;
        const int bi = diag ? (e >> 4) : (p == 0 ? 1 : (p < 3 ? 2 : 3)), bk = diag ? bi : (p == 0 ? 0 : (p < 3 ? p - 1 : p - 3));
        if (act) {
            const LAS float* arow = AM + (16 * bi) * AS + 16 * bi; const LAS float* rhs = AM + (16 * bi) * AS + 16 * bk + n;
            LAS float* dst = (diag ? TF : XF) + (16 * bi) * AS + 16 * bk + n;
            float rv[16];
#pragma unroll
            for (int i = 0; i < 16; ++i) rv[i] = diag ? (i == n ? 1.f : 0.f) : -rhs[i * AS];
            float t[16];
#pragma unroll
            for (int i = 0; i < 16; ++i) t[i] = 0.f;
#pragma unroll
            for (int i = 0; i < 16; ++i) {
                float a0 = rv[i], a1 = 0.f, a2 = 0.f, a3 = 0.f;
#pragma unroll
                for (int jc = 0; jc < (i + 3) / 4; ++jc) { const f32x4 av = *(const LAS f32x4*)(arow + i * AS + 4 * jc);
                    a0 -= av[0] * t[4 * jc]; a1 -= av[1] * t[4 * jc + 1]; a2 -= av[2] * t[4 * jc + 2]; a3 -= av[3] * t[4 * jc + 3]; }
                t[i] = (a0 + a1) + (a2 + a3);
                dst[i * AS] = t[i];
                if (diag) TL[(16 * bi + i) * TS + 16 * bi + n] = (bf16)f2bf(t[i]);
            }
        }
    } else {
        for (int e = tid - 192; e < 1024; e += 320) {
            const int rr = e >> 3, cc = e & 7;
            *(GAS v4u*)((bf16*)(si + SI_KD) + rr * 64 + 8 * cc) = *(const LAS v4u*)(KDT + rr * TS + 8 * cc);
        }
        for (int e = tid - 192; e < 1024; e += 320) {
            const int cq = e >> 4, s = (e >> 2) & 3, qq = e & 3; const float eg = __expf(GC[cq]);
            const v2u lo = *(const LAS v2u*)(QN + cq * RS + 32 * s + 4 * qq), hi = *(const LAS v2u*)(QN + cq * RS + 32 * s + 16 + 4 * qq);
            v4u o; o.x = pk2(bflo(lo.x) * eg, bfhi(lo.x) * eg); o.y = pk2(bflo(lo.y) * eg, bfhi(lo.y) * eg); o.z = pk2(bflo(hi.x) * eg, bfhi(hi.x) * eg); o.w = pk2(bflo(hi.y) * eg, bfhi(hi.y) * eg);
            *(GAS v4u*)((bf16*)(si + SI_QG) + cq * 128 + 32 * s + 8 * qq) = o;
        }
    }
    LDS_SYNC();
    if (dry && stop == 5) return;
#pragma unroll
    for (int d = 1; d < 4; ++d) {
        const int nbk = 4 - d;
        for (int e = tid; e < 256 * nbk; e += NTHR) {
            const int b_ = e >> 8, m_ = (e >> 4) & 15, n_ = e & 15, i_ = d + b_, j_ = b_; float x0 = 0.f, x1 = 0.f;
            const LAS float* br = XF + (16 * i_ + m_) * AS + 16 * j_; const LAS float* tc = TF + (16 * j_) * AS + 16 * j_ + n_;
#pragma unroll
            for (int kk = 0; kk < 16 * d; kk += 4) { const f32x4 bv = *(const LAS f32x4*)(br + kk);
                x0 += bv[0] * tc[kk * AS] + bv[1] * tc[(kk + 1) * AS]; x1 += bv[2] * tc[(kk + 2) * AS] + bv[3] * tc[(kk + 3) * AS]; }
            const float x = x0 + x1;
            TF[(16 * i_ + m_) * AS + 16 * j_ + n_] = x; TL[(16 * i_ + m_) * TS + 16 * j_ + n_] = (bf16)f2bf(x);
        }
        LDS_SYNC();
    }
    if (dry && stop == 6) return;
    {
        const int ntw = wave & 3, m0 = 4 * (wave >> 2);
        bf16x8 tl[4][2], vb[2], kb[4][2], tb[2];
#pragma unroll
        for (int s = 0; s < 2; ++s) {
            vb[s] = *(const LAS bf16x8*)(VBT + (16 * wave + r) * TS + 32 * s + 8 * q); tb[s] = *(const LAS bf16x8*)(TL + (16 * ntw + r) * TS + 32 * s + 8 * q);
#pragma unroll
            for (int m = 0; m < 4; ++m) { tl[m][s] = *(const LAS bf16x8*)(TL + (16 * m + r) * TS + 32 * s + 8 * q); kb[m][s] = *(const LAS bf16x8*)(KBGT + (16 * (m0 + m) + r) * TS + 32 * s + 8 * q); }
        }
        f32x4 au[4], aw[4];
#pragma unroll
        for (int m = 0; m < 4; ++m) { au[m] = (f32x4){0.f, 0.f, 0.f, 0.f}; aw[m] = (f32x4){0.f, 0.f, 0.f, 0.f}; }
#pragma unroll
        for (int s = 0; s < 2; ++s)
#pragma unroll
            for (int m = 0; m < 4; ++m) { au[m] = mfma16(tl[m][s], vb[s], au[m]); aw[m] = mfma16(kb[m][s], tb[s], aw[m]); }
        bf16* ub = (bf16*)(si + SI_U) + (wave * 64 + lane) * 16;
        *(GAS v4u*)ub = (v4u){pk2(au[0][0], au[0][1]), pk2(au[0][2], au[0][3]), pk2(au[1][0], au[1][1]), pk2(au[1][2], au[1][3])};
        *(GAS v4u*)(ub + 8) = (v4u){pk2(au[2][0], au[2][1]), pk2(au[2][2], au[2][3]), pk2(au[3][0], au[3][1]), pk2(au[3][2], au[3][3])};
        bf16* wb = (bf16*)(si + SI_W) + (16 * ntw + r) * 128 + 8 * q + 32 * (m0 >> 1);
        *(GAS v4u*)wb = (v4u){pk2(-aw[0][0], -aw[0][1]), pk2(-aw[0][2], -aw[0][3]), pk2(-aw[1][0], -aw[1][1]), pk2(-aw[1][2], -aw[1][3])};
        *(GAS v4u*)(wb + 32) = (v4u){pk2(-aw[2][0], -aw[2][1]), pk2(-aw[2][2], -aw[2][3]), pk2(-aw[3][0], -aw[3][1]), pk2(-aw[3][2], -aw[3][3])};
    }
    LDS_SYNC();
}

constexpr int SCAN_SL = 2;
constexpr int SC_WS = 272, SC_KS = 144, SC_KOFF = 64 * SC_WS, SC_UOFF = SC_KOFF + 128 * SC_KS, SC_BUF = SC_UOFF + SCAN_SL * 2048;
constexpr int SC_OUT = 2 * SC_BUF, SC_OBUF = SCAN_SL * 6144, SC_GL = SC_OUT + 2 * SC_OBUF;
struct ScanSet { v4u r[9]; };
DI void scan_issue(ScanSet& s, const unsigned char* si, int lid, int dvs0, const unsigned char* pf, unsigned& pfd) {
#pragma unroll
    for (int j = 0; j < 9; ++j) {
        const unsigned char* p = j < 4 ? si + SI_W + (lid + 256 * j) * 16 : (j < 8 ? si + SI_KD + (lid + 256 * (j - 4)) * 16 : si + SI_U + dvs0 * 2048 + lid * 16);
        asm volatile("global_load_dwordx4 %0, %1, off" : "=v"(s.r[j]) : "v"(p) : "memory");
    }
    asm volatile("global_load_dword %0, %1, off" : "+v"(pfd) : "v"(pf) : "memory");
}
DI void scan_wait_put(ScanSet& s, LAS unsigned char* buf, int lid) {
    asm volatile("s_waitcnt vmcnt(31)" : "+v"(s.r[0]), "+v"(s.r[1]), "+v"(s.r[2]), "+v"(s.r[3]), "+v"(s.r[4]), "+v"(s.r[5]), "+v"(s.r[6]), "+v"(s.r[7]), "+v"(s.r[8]) :: "memory");
#pragma unroll
    for (int j = 0; j < 4; ++j) { const int e = lid + 256 * j; *(LAS v4u*)(buf + (e >> 4) * SC_WS + (e & 15) * 16) = s.r[j]; }
#pragma unroll
    for (int j = 4; j < 8; ++j) { const int e = lid + 256 * (j - 4); *(LAS v4u*)(buf + SC_KOFF + (e >> 3) * SC_KS + (e & 7) * 16) = s.r[j]; }
    *(LAS v4u*)(buf + SC_UOFF + lid * 16) = s.r[8];
}
DI void scan_step(f32x4 (&S)[8], LAS unsigned char* buf, LAS unsigned char* ob, float gl, int dvl, int lane) {
    const int r = lane & 15, q = lane >> 4;
    const int woff = r * SC_WS + 16 * q, koff = SC_KOFF + r * SC_KS + 16 * q;
    const v4u ua = *(const LAS v4u*)(buf + SC_UOFF + (dvl * 64 + lane) * 32), ub = *(const LAS v4u*)(buf + SC_UOFF + (dvl * 64 + lane) * 32 + 16);
    bf16x8 Wf[4][4], Kf[8][2];
#pragma unroll
    for (int s = 0; s < 4; ++s)
#pragma unroll
        for (int m = 0; m < 4; ++m) Wf[m][s] = *(const LAS bf16x8*)(buf + woff + 16 * m * SC_WS + 64 * s);
#pragma unroll
    for (int s = 0; s < 2; ++s)
#pragma unroll
        for (int m = 0; m < 8; ++m) Kf[m][s] = *(const LAS bf16x8*)(buf + koff + 16 * m * SC_KS + 64 * s);
    bf16x8 Sb[4];
#pragma unroll
    for (int s = 0; s < 4; ++s) Sb[s] = pack8(S[2 * s][0], S[2 * s][1], S[2 * s][2], S[2 * s][3], S[2 * s + 1][0], S[2 * s + 1][1], S[2 * s + 1][2], S[2 * s + 1][3]);
    f32x4 vn[4];
    vn[0] = (f32x4){bflo(ua.x), bfhi(ua.x), bflo(ua.y), bfhi(ua.y)}; vn[1] = (f32x4){bflo(ua.z), bfhi(ua.z), bflo(ua.w), bfhi(ua.w)};
    vn[2] = (f32x4){bflo(ub.x), bfhi(ub.x), bflo(ub.y), bfhi(ub.y)}; vn[3] = (f32x4){bflo(ub.z), bfhi(ub.z), bflo(ub.w), bfhi(ub.w)};
#pragma unroll
    for (int s = 0; s < 4; ++s)
#pragma unroll
        for (int m = 0; m < 4; ++m) vn[m] = mfma16(Wf[m][s], Sb[s], vn[m]);
#pragma unroll
    for (int m = 0; m < 8; ++m) S[m] = S[m] * gl;
    bf16x8 Vb[2];
#pragma unroll
    for (int s = 0; s < 2; ++s) Vb[s] = pack8(vn[2 * s][0], vn[2 * s][1], vn[2 * s][2], vn[2 * s][3], vn[2 * s + 1][0], vn[2 * s + 1][1], vn[2 * s + 1][2], vn[2 * s + 1][3]);
#pragma unroll
    for (int s = 0; s < 2; ++s)
#pragma unroll
        for (int m = 0; m < 8; ++m) S[m] = mfma16(Kf[m][s], Vb[s], S[m]);
    LAS unsigned char* o = ob + dvl * 6144 + lane * 16;
#pragma unroll
    for (int s = 0; s < 4; ++s) *(LAS bf16x8*)(o + s * 1024) = Sb[s];
#pragma unroll
    for (int s = 0; s < 2; ++s) *(LAS bf16x8*)(o + (4 + s) * 1024) = Vb[s];
}
DI void scan_store(const LAS unsigned char* ob, unsigned char* g, int sid) {
#pragma unroll
    for (int k = 0; k < SC_OBUF / 2048; ++k) *(GAS v4u*)(g + (sid + 128 * k) * 16) = *(const LAS v4u*)(ob + (sid + 128 * k) * 16);
}
#define SCAN_SYNC() do { asm volatile("s_waitcnt lgkmcnt(0)" ::: "memory"); __builtin_amdgcn_s_barrier(); asm volatile("" ::: "memory"); } while (0)
DI void gdn_scan(const Args& a, LAS unsigned char* lds, int sb, int wave, int tid, int lane) {
    const int h = sb % NH, dvs0 = (sb / NH) * SCAN_SL;
    const bool comp = wave < SCAN_SL, loader = wave >= 2 && wave < 6, storer = wave >= 6;
    const int lid = (wave - 2) * 64 + lane, sid = (wave - 6) * 64 + lane;
    const float* GL = (const float*)(a.ws + WS_GL) + h * NCH;
    const bool dry = (a.sub & 256) != 0;
    const int cmask = dry ? 3 : 0x7fffffff;
    const unsigned char* si0 = a.ws + WS_SCANIN + (size_t)h * NCH * SCANIN_ITEM;
    unsigned char* so0 = (dry ? a.ws + 500 * MiB : a.ws + WS_SCANOUT + (size_t)h * NCH * SCANOUT_ITEM) + (size_t)dvs0 * 6144;
    LAS float* GLs = (LAS float*)(lds + SC_GL);
    for (int i = tid; i < NCH; i += NTHR) GLs[i] = GL[i];
    asm volatile("s_waitcnt vmcnt(0)" ::: "memory");
    if (loader) {
        ScanSet A, B, C, D; unsigned pfd = 0u;
        const int pfo = lid < 64 ? (sb / NH) * 8192 + lid * 128 : (lid < 96 ? (int)SI_U + dvs0 * 2048 + (lid - 64) * 128 : (sb / NH) * 8192);
#define SCAN_PF(c) (si0 + (size_t)(((c) + 7 < NCH ? (c) + 7 : NCH - 1) & cmask) * SCANIN_ITEM + pfo)
        scan_issue(A, si0, lid, dvs0, SCAN_PF(-3), pfd); scan_issue(B, si0 + SCANIN_ITEM, lid, dvs0, SCAN_PF(-2), pfd); scan_issue(C, si0 + 2 * SCANIN_ITEM, lid, dvs0, SCAN_PF(-1), pfd); scan_issue(D, si0 + 3 * SCANIN_ITEM, lid, dvs0, SCAN_PF(0), pfd);
        scan_wait_put(A, lds, lid);
        SCAN_SYNC();
#define SCAN_LD(c, SETL, SETW) do { if ((c) < NCH) { const int cl_ = (c) + 4 < NCH ? (c) + 4 : NCH - 1; scan_issue(SETL, si0 + (size_t)(cl_ & cmask) * SCANIN_ITEM, lid, dvs0, SCAN_PF((c) + 1), pfd); \
        scan_wait_put(SETW, lds + (((c) + 1) & 1) * SC_BUF, lid); SCAN_SYNC(); } } while (0)
        for (int c = 0; c < NCH; c += 4) { SCAN_LD(c, A, B); SCAN_LD(c + 1, B, C); SCAN_LD(c + 2, C, D); SCAN_LD(c + 3, D, A); }
#undef SCAN_LD
#undef SCAN_PF
        asm volatile("s_waitcnt vmcnt(0)" : "+v"(A.r[0]), "+v"(B.r[0]), "+v"(C.r[0]), "+v"(D.r[0]), "+v"(pfd) :: "memory");
    } else if (comp) {
        const int r = lane & 15, q = lane >> 4;
        f32x4 S[8];
#pragma unroll
        for (int m = 0; m < 8; ++m) S[m] = (f32x4){0.f, 0.f, 0.f, 0.f};
        SCAN_SYNC();
        for (int c = 0; c < NCH; ++c) { scan_step(S, lds + (c & 1) * SC_BUF, lds + SC_OUT + (c & 1) * SC_OBUF, GLs[c], wave, lane); SCAN_SYNC(); }
        float* out = a.out + O_PGS + (size_t)h * HD * HD; const int dvs = dvs0 + wave;
        if (!dry) {
#pragma unroll
        for (int m = 0; m < 8; ++m)
#pragma unroll
            for (int e = 0; e < 4; ++e) out[(16 * m + 4 * q + e) * HD + 16 * dvs + r] = S[m][e];
        }
    } else {
        SCAN_SYNC();
        for (int c = 0; c < NCH; ++c) { if (storer && c > 0) scan_store(lds + SC_OUT + ((c - 1) & 1) * SC_OBUF, so0 + (size_t)((c - 1) & cmask) * SCANOUT_ITEM, sid); SCAN_SYNC(); }
        if (storer) scan_store(lds + SC_OUT + ((NCH - 1) & 1) * SC_OBUF, so0 + (size_t)((NCH - 1) & cmask) * SCANOUT_ITEM, sid);
    }
}

constexpr int O_QGS = 272, O_QKS = 144, O_ZS = 272;
constexpr int O_QG = 0, O_QK = 64 * O_QGS, O_Z = O_QK + 64 * O_QKS, O_IN = O_Z + 64 * O_ZS;
constexpr int O_OT = 2 * O_IN, O_PART = O_OT + 64 * 272;
struct OutStage { v4u g0, g1, k0, z0, z1; v4u sb[4], vb[2]; };
DI void out_load(OutStage& s, const Args& a, int item, int tid, int lane, int dvs) {
    const int h = item / NCH, c = item % NCH;
    const unsigned char* si = a.ws + WS_SCANIN + (size_t)item * SCANIN_ITEM;
    const unsigned char* so = a.ws + WS_SCANOUT + (size_t)item * SCANOUT_ITEM + (size_t)dvs * 6144;
    const bf16* Z = (const bf16*)(a.ws + WS_Z) + (size_t)CH * c * 1024 + h * HD;
    s.g0 = *(const GAS v4u*)(si + SI_QG + tid * 16); s.g1 = *(const GAS v4u*)(si + SI_QG + (tid + 512) * 16);
    s.k0 = *(const GAS v4u*)(si + SI_QK + tid * 16);
    s.z0 = *(const GAS v4u*)(Z + (size_t)(tid >> 4) * 1024 + (tid & 15) * 8); s.z1 = *(const GAS v4u*)(Z + (size_t)(32 + (tid >> 4)) * 1024 + (tid & 15) * 8);
#pragma unroll
    for (int i = 0; i < 4; ++i) s.sb[i] = *(const GAS v4u*)(so + (i * 64 + lane) * 16);
#pragma unroll
    for (int i = 0; i < 2; ++i) s.vb[i] = *(const GAS v4u*)(so + ((4 + i) * 64 + lane) * 16);
}
DI void out_put(const OutStage& s, LAS unsigned char* buf, int tid) {
    *(LAS v4u*)(buf + O_QG + (tid >> 4) * O_QGS + (tid & 15) * 16) = s.g0; *(LAS v4u*)(buf + O_QG + (32 + (tid >> 4)) * O_QGS + (tid & 15) * 16) = s.g1;
    *(LAS v4u*)(buf + O_QK + (tid >> 3) * O_QKS + (tid & 7) * 16) = s.k0;
    *(LAS v4u*)(buf + O_Z + (tid >> 4) * O_ZS + (tid & 15) * 16) = s.z0; *(LAS v4u*)(buf + O_Z + (32 + (tid >> 4)) * O_ZS + (tid & 15) * 16) = s.z1;
}
DI void out_item(const Args& a, LAS unsigned char* lds, LAS unsigned char* buf, LAS unsigned char* nbuf, const OutStage& cur, const OutStage& nxt, int item, int tid, int lane, int wave) {
    const int h = item / NCH, c = item % NCH, r = lane & 15, q = lane >> 4, dvs = wave;
    LAS float* PART = (LAS float*)(lds + O_PART);
    f32x4 o[4]; float ss[4][4];
    {
        bf16x8 Gf[4][4], Qf[4][2];
#pragma unroll
        for (int s = 0; s < 4; ++s)
#pragma unroll
            for (int m = 0; m < 4; ++m) Gf[m][s] = *(const LAS bf16x8*)(buf + O_QG + (16 * m + r) * O_QGS + 64 * s + 16 * q);
#pragma unroll
        for (int s = 0; s < 2; ++s)
#pragma unroll
            for (int m = 0; m < 4; ++m) Qf[m][s] = *(const LAS bf16x8*)(buf + O_QK + (16 * m + r) * O_QKS + 64 * s + 16 * q);
#pragma unroll
        for (int m = 0; m < 4; ++m) o[m] = (f32x4){0.f, 0.f, 0.f, 0.f};
#pragma unroll
        for (int s = 0; s < 4; ++s)
#pragma unroll
            for (int m = 0; m < 4; ++m) o[m] = mfma16(Gf[m][s], __builtin_bit_cast(bf16x8, cur.sb[s]), o[m]);
#pragma unroll
        for (int s = 0; s < 2; ++s)
#pragma unroll
            for (int m = 0; m < 4; ++m) o[m] = mfma16(Qf[m][s], __builtin_bit_cast(bf16x8, cur.vb[s]), o[m]);
    }
#pragma unroll
    for (int m = 0; m < 4; ++m)
#pragma unroll
        for (int e = 0; e < 4; ++e) ss[m][e] = o[m][e] * o[m][e];
#pragma unroll
    for (int st_ = 1; st_ < 16; st_ <<= 1)
#pragma unroll
        for (int m = 0; m < 4; ++m)
#pragma unroll
            for (int e = 0; e < 4; ++e) ss[m][e] += __shfl_xor(ss[m][e], st_);
    if (r == 0) {
#pragma unroll
        for (int m = 0; m < 4; ++m)
#pragma unroll
            for (int e = 0; e < 4; ++e) PART[wave * 64 + 16 * m + 4 * q + e] = ss[m][e]; }
    LDS_SYNC();
    const int dv = 16 * dvs + r; const float nw = a.in[13][dv];
#pragma unroll
    for (int m = 0; m < 4; ++m)
#pragma unroll
        for (int e = 0; e < 4; ++e) { const int tk = 16 * m + 4 * q + e; float tot = 0.f;
#pragma unroll
            for (int w = 0; w < 8; ++w) tot += PART[w * 64 + tk];
            const float rstd = __builtin_amdgcn_rsqf(tot * (1.f / HD) + EPS);
            const float z = bf2f(*(const LAS bf16*)(buf + O_Z + tk * O_ZS + dv * 2));
            *(LAS bf16*)(lds + O_OT + tk * 272 + dv * 2) = (bf16)f2bf(o[m][e] * rstd * nw * siluf_(z)); }
    out_put(nxt, nbuf, tid);
    LDS_SYNC();
    bf16* MIX = (bf16*)(a.ws + WS_XN) + (size_t)CH * c * DM + h * HD;
    *(GAS v4u*)(MIX + (size_t)(tid >> 4) * DM + (tid & 15) * 8) = *(const LAS v4u*)(lds + O_OT + (tid >> 4) * 272 + (tid & 15) * 16);
    *(GAS v4u*)(MIX + (size_t)(32 + (tid >> 4)) * DM + (tid & 15) * 8) = *(const LAS v4u*)(lds + O_OT + (32 + (tid >> 4)) * 272 + (tid & 15) * 16);
}
DI void gdn_out_phase(const Args& a, LAS unsigned char* lds, int bid, int G, int tid, int lane, int wave) {
    constexpr int NIT = NH * NCH;
    if (bid >= NIT) return;
    OutStage A, B;
    out_load(A, a, bid, tid, lane, wave);
    out_put(A, lds, tid);
    LDS_SYNC();
    for (int it = bid; it < NIT; it += 2 * G) {
        const int n1 = it + G, n2 = it + 2 * G;
        out_load(B, a, n1 < NIT ? n1 : it, tid, lane, wave);
        out_item(a, lds, lds, lds + O_IN, A, B, it, tid, lane, wave);
        if (n1 >= NIT) break;
        out_load(A, a, n2 < NIT ? n2 : n1, tid, lane, wave);
        out_item(a, lds, lds + O_IN, lds, B, A, n1, tid, lane, wave);
    }
    LDS_SYNC();
}

constexpr int S_QS = 0, S_KS = 1024, S_VS = 2048, S_US = 3072, S_WS = 4096, S_KK = 5120, S_QK = 5184, S_GC = 5248, S_BE = 5256, S_RED = 5264, S_SSQ = S_RED + 8192, S_END = S_SSQ + 32;
DI void gdn_sample_item(const Args& a, LAS unsigned char* lds, int item, int tid_in, int lane_in, int wave) {
    int tid = tid_in, lane = lane_in; asm volatile("" : "+v"(tid), "+v"(lane));
    const int b = item >> 3, h = item & 7, R0 = ROW_S + 8 * b;
    LAS float* L = (LAS float*)lds;
    const bf16* QKV = (const bf16*)(a.ws + WS_QKV); const float* BA = (const float*)(a.ws + WS_BA);
    const float* hist = a.in[4] + (size_t)b * 3 * QKVD;
    const int dv = tid & 127, part = tid >> 7;
    const float* S0 = a.in[5] + ((size_t)(b * NH + h) * HD) * HD;
    float s0[32];
#pragma unroll
    for (int k = 0; k < 32; ++k) s0[k] = S0[(size_t)(32 * part + k) * HD + dv];
    float zv[8];
#pragma unroll
    for (int i = 0; i < 8; ++i) zv[i] = part == 0 ? bf2f(((const bf16*)(a.ws + WS_Z))[(size_t)(R0 + i) * 1024 + h * HD + dv]) : 0.f;
    if (tid < 8) {
        const float bb = BA[(size_t)(R0 + tid) * 16 + h], aa = BA[(size_t)(R0 + tid) * 16 + 8 + h];
        L[S_BE + tid] = sigmoidf_(bb); L[S_GC + tid] = -__expf(a.in[11][h]) * softplusf_(aa + a.in[12][h]);
    }
    {
        const int t = wave; float vals[6];
#pragma unroll
        for (int p = 0; p < 6; ++p) {
            const int part = p >> 1, d = lane + 64 * (p & 1), ch = part * GW + h * HD + d; float acc = 0.f;
#pragma unroll
            for (int i = 0; i < 4; ++i) { const int tt = t - 3 + i;
                const float x = tt < 0 ? hist[(size_t)(3 + tt) * QKVD + ch] : bf2f(QKV[(size_t)(R0 + tt) * QKVD + ch]);
                acc += a.in[10][(size_t)i * QKVD + ch] * x; }
            vals[p] = siluf_(acc);
            if (t >= 5) a.out[O_SGC + ((size_t)b * 3 + (t - 5)) * QKVD + ch] = bf2f(QKV[(size_t)(R0 + t) * QKVD + ch]);
        }
        const float sq = wave_sum(vals[0] * vals[0] + vals[1] * vals[1]), sk = wave_sum(vals[2] * vals[2] + vals[3] * vals[3]);
        const float rq = 1.f / sqrtf(sq + EPS) * 0.08838834764831845f, rk = 1.f / sqrtf(sk + EPS);
        L[S_QS + t * 128 + lane] = vals[0] * rq; L[S_QS + t * 128 + lane + 64] = vals[1] * rq;
        L[S_KS + t * 128 + lane] = vals[2] * rk; L[S_KS + t * 128 + lane + 64] = vals[3] * rk;
        L[S_VS + t * 128 + lane] = vals[4]; L[S_VS + t * 128 + lane + 64] = vals[5];
    }
    LDS_SYNC();
    if (tid == 0) { float s = 0.f; for (int i = 0; i < 8; ++i) { s += L[S_GC + i]; L[S_GC + i] = s; } }
    {
        const int p = tid >> 2, qd = tid & 3, i = (p & 63) >> 3, j = p & 7;
        const LAS float* x = L + (p < 64 ? S_KS : S_QS) + i * 128 + 32 * qd; const LAS float* y = L + S_KS + j * 128 + 32 * qd; float s = 0.f;
#pragma unroll
        for (int d = 0; d < 32; d += 4) { const f32x4 xa = *(const LAS f32x4*)(x + d), ya = *(const LAS f32x4*)(y + d); s += (xa[0] * ya[0] + xa[1] * ya[1]) + (xa[2] * ya[2] + xa[3] * ya[3]); }
        s += __shfl_xor(s, 1); s += __shfl_xor(s, 2);
        if (qd == 0) L[(p < 64 ? S_KK : S_QK) + (p & 63)] = s;
    }
    LDS_SYNC();
    if (tid < 256) {
        const int col = tid & 127; const bool isw = tid >= 128; float sol[8];
#pragma unroll
        for (int i = 0; i < 8; ++i) {
            const float bi = L[S_BE + i], gi = L[S_GC + i];
            float v = isw ? bi * __expf(gi) * L[S_KS + i * 128 + col] : bi * L[S_VS + i * 128 + col];
#pragma unroll
            for (int j = 0; j < i; ++j) v -= bi * L[S_KK + i * 8 + j] * __expf(gi - L[S_GC + j]) * sol[j];
            sol[i] = v; L[(isw ? S_WS : S_US) + i * 128 + col] = v;
        }
    }
    LDS_SYNC();
    {
        float pv[8], po[8];
#pragma unroll
        for (int i = 0; i < 8; ++i) { pv[i] = 0.f; po[i] = 0.f; }
#pragma unroll
        for (int k = 0; k < 32; k += 4) {
#pragma unroll
            for (int i = 0; i < 8; ++i) { const f32x4 w4 = *(const LAS f32x4*)(L + S_WS + i * 128 + 32 * part + k), q4 = *(const LAS f32x4*)(L + S_QS + i * 128 + 32 * part + k);
                pv[i] += (w4[0] * s0[k] + w4[1] * s0[k + 1]) + (w4[2] * s0[k + 2] + w4[3] * s0[k + 3]); po[i] += (q4[0] * s0[k] + q4[1] * s0[k + 1]) + (q4[2] * s0[k + 2] + q4[3] * s0[k + 3]); } }
#pragma unroll
        for (int i = 0; i < 8; ++i) { L[S_RED + (part * 16 + i) * 128 + dv] = pv[i]; L[S_RED + (part * 16 + 8 + i) * 128 + dv] = po[i]; }
    }
    LDS_SYNC();
    float vnew[8], o[8];
    const float gl7 = L[S_GC + 7];
#pragma unroll
    for (int i = 0; i < 8; ++i) {
        float sv = 0.f, so = 0.f;
#pragma unroll
        for (int p = 0; p < 4; ++p) { sv += L[S_RED + (p * 16 + i) * 128 + dv]; so += L[S_RED + (p * 16 + 8 + i) * 128 + dv]; }
        vnew[i] = L[S_US + i * 128 + dv] - sv;
        const float gi = L[S_GC + i];
        float oo = so * __expf(gi);
#pragma unroll
        for (int j = 0; j <= i; ++j) oo += L[S_QK + i * 8 + j] * __expf(gi - L[S_GC + j]) * vnew[j];
        o[i] = oo;
    }
    {
        float* Sout = a.out + O_SGS + ((size_t)(b * NH + h) * HD) * HD;
        const float egl = __expf(gl7);
        float vd[8];
#pragma unroll
        for (int i = 0; i < 8; ++i) vd[i] = __expf(gl7 - L[S_GC + i]) * vnew[i];
#pragma unroll
        for (int k = 0; k < 32; k += 4) { f32x4 s4 = {s0[k] * egl, s0[k + 1] * egl, s0[k + 2] * egl, s0[k + 3] * egl};
#pragma unroll
            for (int i = 0; i < 8; ++i) s4 += *(const LAS f32x4*)(L + S_KS + i * 128 + 32 * part + k) * vd[i];
#pragma unroll
            for (int j = 0; j < 4; ++j) Sout[(size_t)(32 * part + k + j) * HD + dv] = s4[j]; }
    }
    if (part == 0) {
#pragma unroll
        for (int i = 0; i < 8; ++i) { const float s = wave_sum(o[i] * o[i]); if (lane == 0) L[S_SSQ + wave * 8 + i] = s; }
    }
    LDS_SYNC();
    if (part == 0) {
        bf16* MIX = (bf16*)(a.ws + WS_XN); const float nw = a.in[13][dv];
#pragma unroll
        for (int i = 0; i < 8; ++i) { const float rstd = 1.f / sqrtf((L[S_SSQ + i] + L[S_SSQ + 8 + i]) * (1.f / HD) + EPS);
            const size_t row = (size_t)R0 + i; const float z = zv[i];
            MIX[row * DM + h * HD + dv] = (bf16)f2bf(o[i] * rstd * nw * siluf_(z)); }
    }
    LDS_SYNC();
}

DI void vt_item(const Args& a, LAS unsigned char* lds, int blk, int tid) {
    const bf16* SQ = (const bf16*)(a.ws + WS_SQKV); bf16* VT = (bf16*)(a.ws + WS_VT);
    LAS bf16* T = (LAS bf16*)lds;
    const int p0 = 64 * blk;
    { const int rr = tid >> 3, cc = tid & 7;
        const GAS v4u* src = (const GAS v4u*)(SQ + (size_t)(p0 + rr) * SQKV_LD + 1280 + 32 * cc);
#pragma unroll
        for (int i = 0; i < 4; ++i) *(LAS v4u*)(T + rr * 264 + 32 * cc + 8 * i) = src[i]; }
    LDS_SYNC();
    { const int ch = tid >> 1, hf = tid & 1;
        unsigned w[16];
#pragma unroll
        for (int i = 0; i < 16; ++i) w[i] = (unsigned)T[(32 * hf + 2 * i) * 264 + ch] | ((unsigned)T[(32 * hf + 2 * i + 1) * 264 + ch] << 16);
        GAS v4u* dst = (GAS v4u*)(VT + (size_t)ch * VT_LD + p0 + 32 * hf);
#pragma unroll
        for (int i = 0; i < 4; ++i) dst[i] = (v4u){w[4 * i], w[4 * i + 1], w[4 * i + 2], w[4 * i + 3]}; }
    LDS_SYNC();
}
DI void kv_outputs(const Args& a, size_t gt, size_t NGT) {
    const bf16* SQ = (const bf16*)(a.ws + WS_SQKV); const bf16* QKV = (const bf16*)(a.ws + WS_QKV);
    for (size_t e = gt; e < 16 * 512; e += NGT) { const int pos = (int)(e >> 9), kv = (int)(e >> 8) & 1, c = (int)(e & 255);
        a.out[O_PMETA + e] = bf2f(SQ[(size_t)pos * SQKV_LD + 1024 + 256 * kv + c]); }
    for (size_t e = gt; e < 128 * 512; e += NGT) { const int pos = NPOS - 128 + (int)(e >> 9), kv = (int)(e >> 8) & 1, c = (int)(e & 255);
        a.out[O_PWIN + e] = bf2f(SQ[(size_t)pos * SQKV_LD + 1024 + 256 * kv + c]); }
    for (size_t e = gt; e < 3 * QKVD; e += NGT) { const int i = (int)(e / QKVD), c = (int)(e % QKVD);
        a.out[O_PGC + e] = bf2f(QKV[(size_t)(NPOS - 3 + i) * QKVD + c]); }
}
DI void swin_output(const Args& a, size_t gt, size_t NGT) {
    const bf16* SQ = (const bf16*)(a.ws + WS_SQKV);
    for (size_t e = gt; e < (size_t)DBATCH * 128 * 512 / 4; e += NGT) {
        const size_t e4 = e * 4; const int b = (int)(e4 >> 16), j = (int)(e4 >> 9) & 127, kv = (int)(e4 >> 8) & 1, c = (int)(e4 & 255);
        f32x4 v;
        if (j < 120) v = *(const GAS f32x4*)(a.in[3] + ((size_t)b * 128 + j + 8) * 512 + 256 * kv + c);
        else { const v2u w = *(const GAS v2u*)(SQ + (size_t)(ROW_S + 8 * b + (j - 120)) * SQKV_LD + 1024 + 256 * kv + c); v = (f32x4){bflo(w.x), bfhi(w.x), bflo(w.y), bfhi(w.y)}; }
        *(GAS f32x4*)(a.out + O_SWIN + e4) = v;
    }
}

DI int crow(int reg, int hh) { return (reg & 3) + 8 * (reg >> 2) + 4 * hh; }
constexpr int PK_RS = 272, PV_RS = 72;
constexpr int P_KOFF = 0, P_VOFF = 64 * PK_RS, P_BUF = P_VOFF + 256 * PV_RS;
struct SwaStage { v4u k[2], v[2]; };
DI void swa_stage_load(SwaStage& s, const bf16* SQ, const bf16* VT, int k0, int tid) {
#pragma unroll
    for (int j = 0; j < 2; ++j) { const int e = tid + 512 * j;
        s.k[j] = *(const GAS v4u*)(SQ + (size_t)(k0 + ((e >> 4) & 31)) * SQKV_LD + 1024 + (e >> 9) * HD + 8 * (e & 15));
        s.v[j] = *(const GAS v4u*)(VT + (size_t)((e >> 9) * HD + ((e >> 2) & 127)) * VT_LD + k0 + 8 * (e & 3)); }
}
DI void swa_stage_put(const SwaStage& s, LAS unsigned char* buf, int tid) {
#pragma unroll
    for (int j = 0; j < 2; ++j) { const int e = tid + 512 * j;
        *(LAS v4u*)(buf + P_KOFF + ((e >> 9) * 32 + ((e >> 4) & 31)) * PK_RS + 16 * (e & 15)) = s.k[j];
        LAS unsigned char* vp = buf + P_VOFF + ((e >> 9) * HD + ((e >> 2) & 127)) * PV_RS + 16 * (e & 3);
        *(LAS v2u*)vp = (v2u){s.v[j].x, s.v[j].y}; *(LAS v2u*)(vp + 8) = (v2u){s.v[j].z, s.v[j].w}; }
}
DI void swa_prompt_block(const Args& a, LAS unsigned char* lds, LAS float* btab  , const LAS int* bucket, int qt, int tid, int lane, int wave) {
    const bf16* SQ = (const bf16*)(a.ws + WS_SQKV); const bf16* VT = (const bf16*)(a.ws + WS_VT); bf16* MIX = (bf16*)(a.ws + WS_XN);
    const int head = wave, kvh = head >> 2, p0 = 32 * qt, ql = lane & 31, hh = lane >> 5, qpos = p0 + ql;
    for (int d = lane; d < 129; d += 64) btab[d] = a.in[8][(d < 128 ? bucket[d] : 31) * NH + head];
    bf16x8 Qf[8];
#pragma unroll
    for (int s = 0; s < 8; ++s) Qf[s] = *(const GAS bf16x8*)(SQ + (size_t)qpos * SQKV_LD + head * HD + 64 * hh + 8 * s);
    const float sink = a.in[14][head];
    float m = sink, l = hh == 0 ? 1.f : 0.f;
    f32x16 O[4];
#pragma unroll
    for (int mt = 0; mt < 4; ++mt)
#pragma unroll
        for (int e = 0; e < 16; ++e) O[mt][e] = 0.f;
    const float scale = 0.08838834764831845f;
    const int t1 = p0 >= 128 ? 1 : 1 + (128 - p0) / 32;
    SwaStage st;
    swa_stage_load(st, SQ, VT, 0, tid);
    swa_stage_put(st, lds, tid);
    LDS_SYNC();
    int par = 0;
    for (int ti = 0; ti < 6; ti = (ti == 0 ? t1 : ti + 1)) {
        const int k0 = ti == 0 ? 0 : p0 - 128 + 32 * (ti - 1);
        const int tn = ti == 0 ? t1 : ti + 1, k0n = tn < 6 ? p0 - 128 + 32 * (tn - 1) : k0;
        swa_stage_load(st, SQ, VT, k0n, tid);
        const LAS unsigned char* buf = lds + par * P_BUF;
        const LAS unsigned char* kb = buf + P_KOFF + (kvh * 32 + ql) * PK_RS + 128 * hh;
        f32x16 St;
#pragma unroll
        for (int e = 0; e < 16; ++e) St[e] = 0.f;
#pragma unroll
        for (int s = 0; s < 8; ++s) St = mfma32(*(const LAS bf16x8*)(kb + 16 * s), Qf[s], St);
        float sc[16]; float mx = -INFINITY;
#pragma unroll
        for (int e = 0; e < 16; ++e) { const int kpos = k0 + crow(e, hh), dist = qpos - kpos;
            const bool ok = ti == 0 ? (kpos < NMETA && dist >= 0) : (kpos >= NMETA && dist >= 0 && dist < WIN);
            const float bias = btab[dist < 0 ? 0 : (dist > 128 ? 128 : dist)];
            sc[e] = ok ? St[e] * scale + bias : -INFINITY; mx = fmaxf(mx, sc[e]); }
        mx = fmaxf(mx, __shfl_xor(mx, 32));
        const float mn = fmaxf(m, mx), alpha = __expf(m - mn); m = mn;
        float ps = 0.f; float p[16];
#pragma unroll
        for (int e = 0; e < 16; ++e) { p[e] = __expf(sc[e] - mn); ps += p[e]; }
        l = l * alpha + ps;
#pragma unroll
        for (int mt = 0; mt < 4; ++mt)
#pragma unroll
            for (int e = 0; e < 16; ++e) O[mt][e] *= alpha;
        bf16x8 Pb[2];
#pragma unroll
        for (int s = 0; s < 2; ++s) Pb[s] = pack8(p[8 * s], p[8 * s + 1], p[8 * s + 2], p[8 * s + 3], p[8 * s + 4], p[8 * s + 5], p[8 * s + 6], p[8 * s + 7]);
#pragma unroll
        for (int mt = 0; mt < 4; ++mt)
#pragma unroll
            for (int s = 0; s < 2; ++s) {
                const LAS unsigned char* vp = buf + P_VOFF + (kvh * HD + 32 * mt + ql) * PV_RS + 32 * s + 8 * hh;
                const v2u lo = *(const LAS v2u*)vp, hi = *(const LAS v2u*)(vp + 16);
                const v4u vv = {lo.x, lo.y, hi.x, hi.y};
                O[mt] = mfma32(__builtin_bit_cast(bf16x8, vv), Pb[s], O[mt]);
            }
        swa_stage_put(st, lds + (par ^ 1) * P_BUF, tid);
        par ^= 1;
        LDS_SYNC();
    }
    l += __shfl_xor(l, 32);
    const float inv = 1.f / l;
    LAS unsigned char* ow = lds + wave * (32 * 272);
#pragma unroll
    for (int mt = 0; mt < 4; ++mt)
#pragma unroll
        for (int g = 0; g < 4; ++g) *(LAS v2u*)(ow + ql * 272 + (32 * mt + 8 * g + 4 * hh) * 2) = (v2u){pk2(O[mt][4 * g] * inv, O[mt][4 * g + 1] * inv), pk2(O[mt][4 * g + 2] * inv, O[mt][4 * g + 3] * inv)};
    asm volatile("s_waitcnt lgkmcnt(0)" ::: "memory");
#pragma unroll
    for (int j = 0; j < 8; ++j) { const int e = lane + 64 * j, rr = e >> 4, cc = e & 15;
        if (p0 + rr < NPOS) *(GAS v4u*)(MIX + (size_t)(p0 + rr) * DM + GW + head * HD + 8 * cc) = *(const LAS v4u*)(ow + rr * 272 + 16 * cc); }
    LDS_SYNC();
}

constexpr int A_QS = 0, A_KV = 32 * 132, A_PS = A_KV + 152 * 132, A_END = A_PS + 32 * 160;
DI void swa_sample_item(const Args& a, LAS unsigned char* lds, const LAS int* bucket, int item, int tid_in, int lane_in, int wave) {
    int tid = tid_in, lane = lane_in; asm volatile("" : "+v"(tid), "+v"(lane));
    const int b = item >> 1, kvh = item & 1, R0 = ROW_S + 8 * b;
    LAS float* L = (LAS float*)lds;
    const bf16* SQ = (const bf16*)(a.ws + WS_SQKV); bf16* MIX = (bf16*)(a.ws + WS_XN);
    { const int qi = tid >> 4, pc = tid & 15, g = qi >> 3, t = qi & 7;
        const v4u w = *(const GAS v4u*)(SQ + (size_t)(R0 + t) * SQKV_LD + (kvh * 4 + g) * HD + 8 * pc);
        LAS float* d = L + A_QS + qi * 132 + 8 * pc;
        *(LAS f32x4*)d = (f32x4){bflo(w.x), bfhi(w.x), bflo(w.y), bfhi(w.y)}; *(LAS f32x4*)(d + 4) = (f32x4){bflo(w.z), bfhi(w.z), bflo(w.w), bfhi(w.w)}; }
#define SWA_FETCH_KV(kvr, which) { \
    _Pragma("unroll") for (int i = 0; i < 10; ++i) { const int e = tid + 512 * i, key = e >> 5, c4 = (e & 31) * 4; kvr[i] = (f32x4){0.f, 0.f, 0.f, 0.f}; \
        if (key < 16) kvr[i] = *(const GAS f32x4*)(a.in[2] + (((size_t)b * 16 + key) * 2 + (which)) * 256 + kvh * HD + c4); \
        else if (key < 144) kvr[i] = *(const GAS f32x4*)(a.in[3] + (((size_t)b * 128 + key - 16) * 2 + (which)) * 256 + kvh * HD + c4); \
        else if (key < 152) { const v2u w = *(const GAS v2u*)(SQ + (size_t)(R0 + key - 144) * SQKV_LD + 1024 + 256 * (which) + kvh * HD + c4); kvr[i] = (f32x4){bflo(w.x), bfhi(w.x), bflo(w.y), bfhi(w.y)}; } } }
#define SWA_PUT_KV(kvr) { _Pragma("unroll") for (int i = 0; i < 10; ++i) { const int e = tid + 512 * i, key = e >> 5, c4 = (e & 31) * 4; if (key < 152) *(LAS f32x4*)(L + A_KV + key * 132 + c4) = kvr[i]; } }
    f32x4 kreg[10], vreg[10];
    SWA_FETCH_KV(kreg, 0)
    SWA_PUT_KV(kreg)
    SWA_FETCH_KV(vreg, 1)
    LDS_SYNC();
    {
        const int qi = tid & 31, kg = tid >> 5, g = qi >> 3, t = qi & 7, head = kvh * 4 + g;
        for (int key = kg; key < 152; key += 16) {
            float s = 0.f;
#pragma unroll 8
            for (int d = 0; d < 128; d += 4) { const f32x4 x = *(const LAS f32x4*)(L + A_QS + qi * 132 + d), y = *(const LAS f32x4*)(L + A_KV + key * 132 + d); s += (x[0] * y[0] + x[1] * y[1]) + (x[2] * y[2] + x[3] * y[3]); }
            bool ok; int bk;
            if (key < 16) { ok = true; bk = 31; }
            else if (key < 144) { const int j = key - 16; ok = j > t; const int dist = 128 + t - j; bk = dist >= 128 ? 31 : bucket[dist]; }
            else { const int t2 = key - 144; ok = t2 <= t; bk = bucket[t - t2 < 0 ? 0 : t - t2]; }
            L[A_PS + qi * 160 + key] = ok ? s * 0.08838834764831845f + a.in[8][bk * NH + head] : -INFINITY;
        }
    }
    LDS_SYNC();
    {
        for (int rr = 0; rr < 4; ++rr) { const int qi = 4 * wave + rr, head = kvh * 4 + (qi >> 3); const float sink = a.in[14][head];
            float v0 = L[A_PS + qi * 160 + lane], v1 = L[A_PS + qi * 160 + 64 + lane], v2 = lane < 24 ? L[A_PS + qi * 160 + 128 + lane] : -INFINITY;
            float mx = fmaxf(fmaxf(v0, v1), fmaxf(v2, sink));
#pragma unroll
            for (int o = 1; o < 64; o <<= 1) mx = fmaxf(mx, __shfl_xor(mx, o));
            const float e0 = __expf(v0 - mx), e1 = __expf(v1 - mx), e2 = lane < 24 ? __expf(v2 - mx) : 0.f;
            const float den = wave_sum(e0 + e1 + e2) + __expf(sink - mx), inv = 1.f / den;
            L[A_PS + qi * 160 + lane] = e0 * inv; L[A_PS + qi * 160 + 64 + lane] = e1 * inv; if (lane < 24) L[A_PS + qi * 160 + 128 + lane] = e2 * inv; }
    }
    LDS_SYNC();
    SWA_PUT_KV(vreg)
    LDS_SYNC();
    {
        const int d = tid & 127, qg = tid >> 7; float o[8];
#pragma unroll
        for (int i = 0; i < 8; ++i) o[i] = 0.f;
        for (int key = 0; key < 152; ++key) { const float v = L[A_KV + key * 132 + d];
#pragma unroll
            for (int i = 0; i < 8; ++i) o[i] += L[A_PS + (8 * qg + i) * 160 + key] * v; }
#pragma unroll
        for (int i = 0; i < 8; ++i) { const int qi = 8 * qg + i, g = qi >> 3, t = qi & 7; MIX[(size_t)(R0 + t) * DM + GW + (kvh * 4 + g) * HD + d] = (bf16)f2bf(o[i]); }
    }
    LDS_SYNC();
#undef SWA_FETCH_KV
#undef SWA_PUT_KV
}

#ifndef MK_PER_PHASE
#define MK_PER_PHASE 0
#endif
constexpr int N_PHASES = 10;
constexpr int L_BUCKET = 139264, L_BTAB = 139776;


__global__ void __launch_bounds__(NTHR, 2) mega_fwd(Args args) {
    extern __shared__ __attribute__((aligned(16))) unsigned char lds_raw[];
    LAS unsigned char* lds = (LAS unsigned char*)lds_raw;
    const int tid = threadIdx.x, lane = tid & 63, wave = __builtin_amdgcn_readfirstlane(tid >> 6);
    const int G = gridDim.x, bid = blockIdx.x;
    const int gw = bid * NWAVES + wave, NGW = G * NWAVES;
    volatile LAS unsigned* MISC = (volatile LAS unsigned*)(lds + MISC_OFF);
    for (int u = tid; u < 64; u += NTHR) MISC[u] = 0u;
    __syncthreads();
    XcdBarrier bar; bar.bar = (unsigned*)(args.ws + WS_CTL) + CW_BAR; bar.x = 0; bar.st = nullptr;
    if (!MK_PER_PHASE) bar = xcd_barrier_post((unsigned*)(args.ws + WS_CTL) + CW_BAR, MISC + 8);
    const int lo = args.ph_lo, hi = args.ph_hi;
#ifndef PH_MASK
#define PH_MASK 0x3ff
#endif
#define IN(k) (((PH_MASK >> (k)) & 1) && lo <= (k) && (k) < hi)
#ifndef REP_MASK
#define REP_MASK 0
#endif
#define SEAM(k) do { if (IN(k) && IN((k) + 1)) xcd_barrier(bar); } while (0)

    if (IN(0)) { p0_prologue(args, lds, gw, NGW, lane, wave); }
    SEAM(0);
    if (IN(1)) {
        pg8::Gemm g{(const pg8::bf16_t*)(args.ws + WS_XN), (const pg8::bf16_t*)(args.ws + WS_WIN), MPAD / 256, NPROJ / 256, DM};
        pg8::StaticOrder S; S.init(g.nM, g.nN, G, bid, g.K / 64);
        EpiProj E{(bf16*)(args.ws + WS_QKV), (bf16*)(args.ws + WS_Z), (bf16*)(args.ws + WS_SQKV)};
        pg8::gemm_phase<EpiProj, pg8::AMapStd>(lds, g, S, E);
        if (!(args.sub & 128)) p1_ba(args, lds, bid, G, tid, lane, wave);
    }
    SEAM(1);
    if (IN(2)) {
        constexpr int N_PREP = NH * NCH, N_SAMP = DBATCH * NH, N_VT = 257;
        if (args.sub & 8) { PrepIn pin; prep_fetch(pin, args, bid, tid, lane);
            for (int e = tid; e < 64 * TS * 2 / 16; e += NTHR) *(LAS v4u*)(lds + L_TL + e * 16) = (v4u){0u, 0u, 0u, 0u};
            for (int it = bid; it < N_PREP; it += G) gdn_prep_item(args, lds, it, it + G < N_PREP ? it + G : -1, pin, tid, lane, wave); }
        constexpr int N_S2 = 248;
        if ((args.sub & 16) && bid >= N_PREP % 256 && bid - N_PREP % 256 < N_S2) gdn_sample_item(args, lds, bid - N_PREP % 256, tid, lane, wave);
        if (args.sub & 32) for (int it = G - 1 - bid; it < N_VT; it += G) vt_item(args, lds, it, tid);
        if (args.sub & 32) kv_outputs(args, (size_t)bid * NTHR + tid, (size_t)G * NTHR);
    }
    SEAM(2);
    constexpr int SCAN_BLOCKS = NH * 8 / SCAN_SL;
    if (IN(3)) {
        LAS int* bucket = (LAS int*)(lds + L_BUCKET);
        if (tid < 128) { const int n = tid; int bk = n;
            if (n >= 16) { const int lg = 16 + (int)(logf((float)n / 16.0f) / 2.0794415416798357f * 16.0f); bk = lg < 31 ? lg : 31; }
            bucket[tid] = bk; }
        __syncthreads();
        if (bid < SCAN_BLOCKS) { if (args.sub & 1) gdn_scan(args, lds, bid, wave, tid, lane); }
        else {
            const int nb = G - SCAN_BLOCKS, b2 = bid - SCAN_BLOCKS;
            constexpr int N_PS = 513, N_SS = DBATCH * KVH, N_SG = DBATCH * NH - 248;
            LAS float* btab = (LAS float*)(lds + L_BTAB) + wave * 160;
            for (int it = b2; it < N_PS + N_SS + N_SG; it += nb) {
                if (it < N_PS) { if (args.sub & 4) swa_prompt_block(args, lds, btab, bucket, it, tid, lane, wave); }
                else if (it < N_PS + N_SS) { if (args.sub & 2) swa_sample_item(args, lds, bucket, it - N_PS, tid, lane, wave); }
                else { if (args.sub & 16) gdn_sample_item(args, lds, 248 + it - N_PS - N_SS, tid, lane, wave); }
            }
            if (args.sub & 32) { swin_output(args, (size_t)b2 * NTHR + tid, (size_t)nb * NTHR); p5_ffn_weights(args, lds, b2 * NWAVES + wave, nb * NWAVES, lane, wave, 0); p5_ffn_weights(args, lds, b2 * NWAVES + wave, nb * NWAVES, lane, wave, 1); }
        }
    }
    SEAM(3);
    if (IN(4)) { gdn_out_phase(args, lds, bid, G, tid, lane, wave); }
    SEAM(4);
    if (IN(5)) {
        pg8::Gemm g{(const pg8::bf16_t*)(args.ws + WS_XN), (const pg8::bf16_t*)(args.ws + WS_WOUT), 64, DM / 256, DM};
        pg8::StaticOrder S; S.init(64, g.nN, G, bid, g.K / 64, 5, NSPLIT);
        EpiSplit E{(bf16*)(args.ws + WS_MIXOUT), DM, (float*)(args.ws + WS_PART), TAIL_ROW0, TAIL_ROWS};
        pg8::gemm_phase<EpiSplit, pg8::AMapStd>(lds, g, S, E);
    }
    SEAM(5);
    if (IN(6)) { p6_rows(args, gw, NGW, lane); }
    SEAM(6);
    if (IN(7)) {
        pg8::Gemm g{(const pg8::bf16_t*)(args.ws + WS_XN), (const pg8::bf16_t*)(args.ws + WS_WGU), FFN_NM, DFF / 128, DM};
        pg8::StaticOrder S; S.init(g.nM, g.nN, G, bid, g.K / 64);
        EpiFfn E{(bf16*)(args.ws + WS_ACT), args.in[22], args.in[6], args.out, (LAS float*)(lds + XCH_OFF)};
        pg8::gemm_phase<EpiFfn, AMapFfn>(lds, g, S, E);
    }
    SEAM(7);
    if (IN(8)) {
        pg8::Gemm g{(const pg8::bf16_t*)(args.ws + WS_ACT), (const pg8::bf16_t*)(args.ws + WS_WDOWN), 64, DM / 256, DFF};
        pg8::StaticOrder S; S.init(64, g.nN, G, bid, g.K / 64, 5, NSPLIT);
        EpiSplit E{(bf16*)(args.ws + WS_XN), DM, (float*)(args.ws + WS_PART), TAIL_ROW0, TAIL_ROWS};
        pg8::gemm_phase<EpiSplit, pg8::AMapStd>(lds, g, S, E);
    }
    SEAM(8);
    if (IN(9)) { p9_rows(args, lds, tid, gw, NGW, lane); }
#undef IN
#undef SEAM
}

extern "C" void kernel_launch(void* const* d_in, const int* in_sizes, int n_in, void* d_out, int out_size, void* d_ws, size_t ws_size, hipStream_t stream) {
    static int grid = 0;
    if (grid == 0) {
        if (n_in != 24 || (size_t)out_size != O_END || ws_size < WS_END) { fprintf(stderr, "kernel_launch: unexpected shapes (n_in %d, out %d, ws %zu)\n", n_in, out_size, ws_size); grid = -1; return; }
        int dev = 0, cus = 0;
        if (hipGetDevice(&dev) != hipSuccess || hipDeviceGetAttribute(&cus, hipDeviceAttributeMultiprocessorCount, dev) != hipSuccess) { grid = -1; return; }
        if (hipFuncSetAttribute((const void*)mega_fwd, hipFuncAttributeMaxDynamicSharedMemorySize, LDS_BYTES) != hipSuccess) { fprintf(stderr, "kernel_launch: hipFuncSetAttribute failed\n"); grid = -1; return; }
        (void)hipGetLastError();
        grid = cus;
    }
    if (grid < 0) return;
    if (hipMemsetAsync((char*)d_ws + WS_CTL, 0, CTL_ZERO_BYTES, stream) != hipSuccess) return;
    Args a{};
    for (int i = 0; i < 24; ++i) a.in[i] = (const float*)d_in[i];
    a.out = (float*)d_out; a.ws = (unsigned char*)d_ws; a.sub = 63;
#if MK_PER_PHASE
#ifndef REP_SUB
#define REP_SUB 63
#endif
#ifndef REP_N
#define REP_N 1
#endif
    for (int p = 0; p < N_PHASES; ++p) for (int rep = 0; rep < 1 + REP_N * ((REP_MASK >> p) & 1); ++rep) { a.ph_lo = p; a.ph_hi = p + 1; a.sub = rep ? REP_SUB : 63; hipLaunchKernelGGL(mega_fwd, dim3(grid), dim3(NTHR), LDS_BYTES, stream, a); }
#else
    a.ph_lo = 0; a.ph_hi = N_PHASES;
    hipLaunchKernelGGL(mega_fwd, dim3(grid), dim3(NTHR), LDS_BYTES, stream, a);
#endif
}
```

```cpp
#include <hip/hip_runtime.h>
#include <cstdio>
#include <cstdint>

namespace pg8 {
#define PG8_LAS __attribute__((address_space(3)))
typedef unsigned short bf16_t;
typedef short bf16x8 __attribute__((ext_vector_type(8)));
typedef float f32x4 __attribute__((ext_vector_type(4)));
typedef unsigned u32x4 __attribute__((ext_vector_type(4)));
constexpr int BM = 256, BK = 64, HALF = 128, HTB = HALF * BK * 2  , STAGE_BYTES = 8 * HTB, NXCD = 8, WGM = 4;

__host__ __device__ __forceinline__ int lds_byte(int r, int c) { const int st = (r >> 4) * 2 + (c >> 5), rr = r & 15, cc = c & 31, ob = rr * 64 + cc * 2; return st * 1024 + (ob ^ (((ob >> 9) & 1) << 5)); }
__host__ __device__ __forceinline__ void stage_rc(int b, int& R, int& C) { const int st = b / 1024, sb = b % 1024, swz = sb ^ (((sb >> 9) & 1) << 5); R = (st >> 1) * 16 + swz / 64; C = (st & 1) * 32 + (swz % 64) / 2; }
__host__ __device__ __forceinline__ int perm32(int rho) { const int n = rho >> 4, i = rho & 15; return 8 * (i >> 2) + 4 * n + (i & 3); }

struct Unit { int pm, pn, kt0, nk, sp; };
struct Gemm { const bf16_t* A; const bf16_t* Bt; int nM, nN, K; };

struct StaticOrder {
    int nM, nN, nwg, G, c, ktiles, nMt, nsp;
    __host__ __device__ void init(int nM_, int nN_, int G_, int c_, int ktiles_, int nMt_ = 0, int nsp_ = 1) { nM = nM_; nN = nN_; nwg = nM * nN; G = G_; c = c_; ktiles = ktiles_; nMt = nMt_; nsp = nsp_; }
    __host__ __device__ __forceinline__ bool next(int i, Unit& u) const {
        const long L = (long)i * G + c;
        const bool tail = L >= nwg;
        const int Lt = (int)(L - nwg), nt_ = nMt * nN;
        if (tail && Lt >= nt_ * nsp) return false;
        int wgid = tail ? 0 : (int)L; { const int q = nwg / NXCD, r = nwg % NXCD, xcd = wgid % NXCD, off = wgid / NXCD; wgid = (xcd < r ? xcd * (q + 1) : r * (q + 1) + (xcd - r) * q) + off; }
        const int nig = WGM * nN, gid = wgid / nig, fm = gid * WGM, gsz = (nM - fm) < WGM ? (nM - fm) : WGM;
        const int sp = tail ? Lt / (nt_ > 0 ? nt_ : 1) : -1, w = tail ? Lt % (nt_ > 0 ? nt_ : 1) : 0;
        const int prs = ktiles / 2, qs = prs / nsp, rs = prs % nsp, spc = sp < 0 ? 0 : sp;
        const int nks = 2 * (qs + (spc < rs ? 1 : 0)), kts = 2 * (spc * qs + (spc < rs ? spc : rs));
        Unit r_;
        r_.pm = tail ? nM + w / nN : fm + ((wgid % nig) % gsz);
        r_.pn = tail ? w % nN : (wgid % nig) / gsz;
        r_.kt0 = tail ? kts : 0; r_.nk = tail ? nks : ktiles; r_.sp = sp;
        u = r_; return true;
    }
};

struct AMapStd {
    static constexpr int HSTEP_ROWS = 128;
    static __host__ __device__ __forceinline__ int row_in_half(int R) { return R; }
    static __host__ __device__ __forceinline__ long base_row(int pm) { return (long)pm * 256; }
};

__device__ __forceinline__ unsigned cvt_pk_bf16(float lo, float hi) { unsigned r; asm volatile("v_cvt_pk_bf16_f32 %0, %1, %2" : "=v"(r) : "v"(lo), "v"(hi)); return r; }

template <class Epi, class AM, bool ALIGN_EPI = true>
__device__ __forceinline__ void gemm_phase(PG8_LAS unsigned char* lds, const Gemm g, const StaticOrder& S, const Epi& E) {
    const int tid = threadIdx.x, wid = __builtin_amdgcn_readfirstlane(tid >> 6), lane = tid & 63, wr = wid >> 2, wc = wid & 3, fr = lane & 15, fq = lane >> 4;
    const int K = g.K;
    unsigned voffA[2], voffB[2];
#pragma unroll
    for (int i = 0; i < 2; ++i) { int R, C; stage_rc(tid * 16 + i * 8192, R, C); const int Rb = Epi::PERM ? ((R & ~31) + perm32(R & 31)) : R;
        voffA[i] = (unsigned)(AM::row_in_half(R) * K + C) * 2u; voffB[i] = (unsigned)(Rb * K + C) * 2u; }
    const size_t kstep = (size_t)(BK * 2);
    const size_t hstepB = (size_t)HALF * K * 2;
    const size_t hstepA = (size_t)AM::HSTEP_ROWS * K * 2;
    const size_t tstepB = 2 * hstepB;
    const size_t rowb = (size_t)K * 2;
    const unsigned ldsw = (unsigned)wid * 1024u;
    const int aoff = lds_byte(wr * 64 + fr, fq * 8), boff = lds_byte(wc * 32 + fr, fq * 8);
#define PG8_SA(b, h) (((b) * 2 + (h)) * HTB)
#define PG8_SB(b, h) ((4 + (b) * 2 + (h)) * HTB)
#define PG8_STAGE(bufoff, gbase, voff) do { _Pragma("unroll") for (int _i = 0; _i < 2; ++_i) \
        __builtin_amdgcn_global_load_lds((const unsigned*)((const char*)(gbase) + (voff)[_i]), (PG8_LAS unsigned*)(lds + (bufoff) + ldsw + _i * 8192), 16, 0, 0); } while (0)
#define PG8_LDA(dst, b, h) do { _Pragma("unroll") for (int m = 0; m < 4; ++m) _Pragma("unroll") for (int k = 0; k < 2; ++k) dst[m][k] = *(const PG8_LAS bf16x8*)(lds + PG8_SA(b, h) + aoff + m * 2048 + k * 1024); } while (0)
#define PG8_LDB(dst, b, h) do { _Pragma("unroll") for (int n = 0; n < 2; ++n) _Pragma("unroll") for (int k = 0; k < 2; ++k) dst[n][k] = *(const PG8_LAS bf16x8*)(lds + PG8_SB(b, h) + boff + n * 2048 + k * 1024); } while (0)
#define PG8_MMA(ai, bj, At, Bt) do { __builtin_amdgcn_s_setprio(1); _Pragma("unroll") for (int m = 0; m < 4; ++m) _Pragma("unroll") for (int n = 0; n < 2; ++n) _Pragma("unroll") for (int k = 0; k < 2; ++k) \
        acc[ai][bj][m][n] = __builtin_amdgcn_mfma_f32_16x16x32_bf16(Bt[n][k], At[m][k], acc[ai][bj][m][n], 0, 0, 0); __builtin_amdgcn_s_setprio(0); } while (0)
#define PG8_WAIT_V(n) asm volatile("s_waitcnt vmcnt(" #n ")" ::: "memory")
#define PG8_WAIT_L(n) asm volatile("s_waitcnt lgkmcnt(" #n ")" ::: "memory")
#define PG8_BAR __builtin_amdgcn_s_barrier()
#define PG8_SCHED __builtin_amdgcn_sched_barrier(0)
    Unit cur, nxt; int ui = 0;
    if (!S.next(0, cur)) return;
    f32x4 acc[2][2][4][2];
#pragma unroll
    for (int a = 0; a < 2; ++a)
#pragma unroll
        for (int b = 0; b < 2; ++b)
#pragma unroll
            for (int m = 0; m < 4; ++m)
#pragma unroll
                for (int n = 0; n < 2; ++n) acc[a][b][m][n] = (f32x4){0.f, 0.f, 0.f, 0.f};
    bf16x8 At[4][2], B0[2][2], B1[2][2];
    const char* cA = (const char*)g.A + (size_t)AM::base_row(cur.pm) * rowb + (size_t)cur.kt0 * kstep; const char* cB = (const char*)g.Bt + (size_t)cur.pn * tstepB + (size_t)cur.kt0 * kstep;
    PG8_STAGE(PG8_SB(0, 0), cB, voffB); PG8_STAGE(PG8_SB(0, 1), cB + hstepB, voffB); PG8_STAGE(PG8_SA(0, 0), cA, voffA); PG8_STAGE(PG8_SA(0, 1), cA + hstepA, voffA);
    if (wr == 1) PG8_BAR;
    PG8_WAIT_V(2); PG8_BAR;
    PG8_STAGE(PG8_SB(1, 0), cB + kstep, voffB); PG8_STAGE(PG8_SA(1, 0), cA + kstep, voffA); PG8_STAGE(PG8_SB(1, 1), cB + hstepB + kstep, voffB);
    PG8_WAIT_V(6); PG8_BAR;
    for (;;) {
        const bool has_next = S.next(ui + 1, nxt);
        const char* nA = has_next ? (const char*)g.A + (size_t)AM::base_row(nxt.pm) * rowb + (size_t)nxt.kt0 * kstep : cA; const char* nB = has_next ? (const char*)g.Bt + (size_t)nxt.pn * tstepB + (size_t)nxt.kt0 * kstep : cB;
        const int nt = cur.nk;
        for (int t = 0; t < nt; t += 2) {
            const bool last = (t == nt - 2);
            const char* a1 = cA + (size_t)(t + 1) * kstep;
            const char* a2 = last ? nA : cA + (size_t)(t + 2) * kstep; const char* b2 = last ? nB : cB + (size_t)(t + 2) * kstep;
            const char* a3 = a2 + kstep; const char* b3 = b2 + kstep;
            PG8_LDB(B0, 0, 0); PG8_LDB(B1, 0, 1); PG8_SCHED; PG8_LDA(At, 0, 0); PG8_STAGE(PG8_SA(1, 1), a1 + hstepA, voffA);
            PG8_WAIT_V(8); PG8_WAIT_L(0); PG8_BAR; PG8_MMA(0, 0, At, B0); PG8_MMA(0, 1, At, B1); PG8_BAR; PG8_SCHED;
            PG8_LDA(At, 0, 1); PG8_STAGE(PG8_SB(0, 0), b2, voffB); PG8_STAGE(PG8_SB(0, 1), b2 + hstepB, voffB); PG8_STAGE(PG8_SA(0, 0), a2, voffA);
            PG8_WAIT_V(8); PG8_WAIT_L(0); PG8_BAR; PG8_MMA(1, 0, At, B0); PG8_MMA(1, 1, At, B1); PG8_BAR; PG8_SCHED;
            PG8_LDB(B0, 1, 0); PG8_LDB(B1, 1, 1); PG8_SCHED; PG8_LDA(At, 1, 0); PG8_STAGE(PG8_SA(0, 1), a2 + hstepA, voffA);
            PG8_WAIT_V(8); PG8_WAIT_L(0); PG8_BAR; PG8_MMA(0, 0, At, B0); PG8_MMA(0, 1, At, B1); PG8_BAR; PG8_SCHED;
            PG8_LDA(At, 1, 1); PG8_STAGE(PG8_SB(1, 0), b3, voffB); PG8_STAGE(PG8_SB(1, 1), b3 + hstepB, voffB); PG8_STAGE(PG8_SA(1, 0), a3, voffA);
            PG8_WAIT_V(8); PG8_WAIT_L(0); PG8_BAR; PG8_MMA(1, 0, At, B0); PG8_MMA(1, 1, At, B1); PG8_BAR; PG8_SCHED;
        }
        if constexpr (ALIGN_EPI) { if (wr == 0) PG8_BAR; }
        E(acc, cur, wr, wc, fr, fq);
        if (!has_next) break;
#pragma unroll
        for (int a = 0; a < 2; ++a)
#pragma unroll
            for (int b = 0; b < 2; ++b)
#pragma unroll
                for (int m = 0; m < 4; ++m)
#pragma unroll
                    for (int n = 0; n < 2; ++n) acc[a][b][m][n] = (f32x4){0.f, 0.f, 0.f, 0.f};
        cur = nxt; cA = nA; cB = nB; ++ui;
        if constexpr (ALIGN_EPI) { if (wr == 1) PG8_BAR; }
    }
    PG8_WAIT_V(0);
    if constexpr (!ALIGN_EPI) { if (wr == 0) PG8_BAR; }
    PG8_BAR;
#undef PG8_SA
#undef PG8_SB
#undef PG8_STAGE
#undef PG8_LDA
#undef PG8_LDB
#undef PG8_MMA
#undef PG8_WAIT_V
#undef PG8_WAIT_L
#undef PG8_BAR
#undef PG8_SCHED
}
}

constexpr int NWAVES = 8, NTHR = 512;
constexpr int DM = 2048, NMETA = 16, SEQ = 16384, NPOS = NMETA + SEQ  , DBATCH = 128, DSEQ = 8, NSAMP = DBATCH * DSEQ;
constexpr int ROW_S = 16448;
constexpr int MPAD = 17664;
constexpr int HD = 128, NH = 8, KVH = 2, GW = 1024, QKVD = 3072, DFF = 5632, NCH = 257, CH = 64;
constexpr int PAST = 16384, WIN = 128;
constexpr float EPS = 1e-6f;
constexpr int NPROJ = 5632, SQKV_LD = 1536;

constexpr size_t O_YP = 0, O_YS = O_YP + (size_t)SEQ * DM, O_PMETA = O_YS + (size_t)NSAMP * DM, O_PWIN = O_PMETA + 16 * 2 * 2 * 128, O_PGC = O_PWIN + 128 * 2 * 2 * 128,
                 O_PGS = O_PGC + 3 * QKVD, O_PFC = O_PGS + (size_t)NH * HD * HD, O_SWIN = O_PFC + 2 * DFF, O_SGC = O_SWIN + (size_t)DBATCH * 128 * 512, O_SGS = O_SGC + (size_t)DBATCH * 3 * QKVD,
                 O_SFC = O_SGS + (size_t)DBATCH * NH * HD * HD, O_END = O_SFC + (size_t)DBATCH * 2 * DFF;

constexpr size_t MiB = 1u << 20;
constexpr size_t WS_CTL = 0, CTL_ZERO_BYTES = 64 * 1024;
constexpr size_t WS_BA = 1 * MiB;
constexpr size_t WS_GL = 3 * MiB;
constexpr size_t WS_WIN = 4 * MiB;
constexpr size_t WS_WBA = 27 * MiB;
constexpr size_t WS_WOUT = 28 * MiB;
constexpr size_t WS_XN = 36 * MiB;
constexpr size_t WS_VT = 106 * MiB;
constexpr int VT_LD = 16512;
constexpr size_t WS_QKV = 116 * MiB;
constexpr size_t WS_Z = 220 * MiB;
constexpr size_t WS_SQKV = 255 * MiB;
constexpr size_t WS_SCANIN = 307 * MiB;
constexpr size_t SCANIN_ITEM = 73728, SI_W = 0, SI_KD = 16384, SI_U = 32768, SI_QG = 49152, SI_QK = 65536;
constexpr size_t WS_SCANOUT = WS_QKV;
constexpr size_t SCANOUT_ITEM = 49152;
constexpr size_t WS_WGU = 452 * MiB;
constexpr size_t WS_WDOWN = 4 * MiB;
constexpr size_t WS_MIXOUT = 116 * MiB;
constexpr size_t WS_ACT = 255 * MiB;
constexpr size_t WS_PART = 186 * MiB;
constexpr int TAIL_ROW0 = 16384, TAIL_ROWS = 1280, NSPLIT = 4;
constexpr size_t WS_END = 496 * MiB;
static_assert(WS_WIN + (size_t)NPROJ * DM * 2 <= WS_WBA && WS_WOUT + (size_t)DM * DM * 2 <= WS_XN && WS_XN + (size_t)MPAD * DM * 2 <= WS_VT, "ws map 1");
static_assert(WS_VT + (size_t)2 * 128 * VT_LD * 2 <= WS_QKV && WS_QKV + (size_t)MPAD * QKVD * 2 <= WS_Z && WS_Z + (size_t)MPAD * 1024 * 2 <= WS_SQKV, "ws map 2");
static_assert(WS_SQKV + (size_t)MPAD * SQKV_LD * 2 <= WS_SCANIN && WS_SCANIN + (size_t)NH * NCH * SCANIN_ITEM <= WS_WGU, "ws map 3");
static_assert(WS_SCANOUT + (size_t)NH * NCH * SCANOUT_ITEM <= WS_Z, "ws map 4");
static_assert(WS_WGU + (size_t)2 * DFF * DM * 2 <= WS_END && WS_WDOWN + (size_t)DM * DFF * 2 <= WS_WBA && WS_MIXOUT + (size_t)MPAD * DM * 2 <= WS_Z && WS_ACT + (size_t)MPAD * DFF * 2 <= WS_WGU && WS_END <= 512 * MiB, "ws map 5");
constexpr int CW_BAR = 1024;

constexpr int RING_BYTES = 131072;
constexpr int MISC_OFF = 147456 - 256;
constexpr int XCH_OFF = RING_BYTES;
constexpr int LDS_BYTES = 147456;

#define GAS __attribute__((address_space(1)))
#define LAS __attribute__((address_space(3)))
typedef unsigned short bf16;
typedef unsigned v4u __attribute__((ext_vector_type(4)));
typedef unsigned v2u __attribute__((ext_vector_type(2)));
typedef float f32x4 __attribute__((ext_vector_type(4)));
typedef float f32x16 __attribute__((ext_vector_type(16)));
typedef short bf16x8 __attribute__((ext_vector_type(8)));
typedef GAS unsigned gu32;
#define RLX_AGENT __ATOMIC_RELAXED, __HIP_MEMORY_SCOPE_AGENT
#define DI __device__ __forceinline__
typedef float f32x2_ __attribute__((ext_vector_type(2)));
typedef __bf16 bf16x2_ __attribute__((ext_vector_type(2)));
DI unsigned pk2(float lo, float hi) { const f32x2_ v = {lo, hi}; return __builtin_bit_cast(unsigned, __builtin_convertvector(v, bf16x2_)); }
DI unsigned f2bf(float f) { return pk2(f, 0.f) & 0xffffu; }
DI float bf2f(unsigned short b) { return __builtin_bit_cast(float, (unsigned)b << 16); }
DI float bflo(unsigned w) { return __builtin_bit_cast(float, w << 16); }
DI float bfhi(unsigned w) { return __builtin_bit_cast(float, w & 0xffff0000u); }
#define LDS_SYNC() do { asm volatile("s_waitcnt lgkmcnt(0)" ::: "memory"); __builtin_amdgcn_s_barrier(); asm volatile("" ::: "memory"); } while (0)
DI float wave_sum(float v) {
#pragma unroll
    for (int o = 1; o < 64; o <<= 1) v += __shfl_xor(v, o);
    return v;
}
DI float sigmoidf_(float x) { return __builtin_amdgcn_rcpf(1.f + __expf(-x)); }
DI float siluf_(float x) { return x * __builtin_amdgcn_rcpf(1.f + __expf(-x)); }
DI float softplusf_(float x) { return x > 20.f ? x : log1pf(__expf(x)); }
DI f32x4 mfma16(bf16x8 a, bf16x8 b, f32x4 c) { return __builtin_amdgcn_mfma_f32_16x16x32_bf16(a, b, c, 0, 0, 0); }
DI f32x16 mfma32(bf16x8 a, bf16x8 b, f32x16 c) { return __builtin_amdgcn_mfma_f32_32x32x16_bf16(a, b, c, 0, 0, 0); }
DI bf16x8 pack8(float a0, float a1, float a2, float a3, float a4, float a5, float a6, float a7) {
    v4u p; p.x = pk2(a0, a1); p.y = pk2(a2, a3); p.z = pk2(a4, a5); p.w = pk2(a6, a7); return __builtin_bit_cast(bf16x8, p);
}

#define XB_TMO      128
#define XB_XCNT(j)  (256  + 64 * (j))
#define XB_XSUB(j)  (1280 + 64 * (j))
#define XB_XGEN(j)  (2304 + 64 * (j))
#define XB_TOP      3328
#define XB_TOPGEN   3392
#define XCD_BAR_WORDS 3456
#define XB_SPIN_CAP (1u << 18)
DI unsigned xb_ld(unsigned* p)              { return __hip_atomic_load(p, __ATOMIC_RELAXED, __HIP_MEMORY_SCOPE_AGENT); }
DI unsigned xb_add(unsigned* p, unsigned v) { return __hip_atomic_fetch_add(p, v, __ATOMIC_RELAXED, __HIP_MEMORY_SCOPE_AGENT); }
DI unsigned xb_xcc_id() { return (unsigned)__builtin_amdgcn_s_getreg((3 << 11) | 20) & 0xFu; }
#define XB_SPIN(cond, bar) do { unsigned _sp = 0; while (cond) { __builtin_amdgcn_s_sleep(1); \
    if ((++_sp & 255u) == 0u) { if (xb_ld(&(bar)[XB_TMO])) break; if (_sp > XB_SPIN_CAP) { atomicAdd(&(bar)[XB_TMO], 1u); break; } } } } while (0)
struct XcdBarrier { unsigned* bar; unsigned x; volatile LAS unsigned* st; };
DI XcdBarrier xcd_barrier_post(unsigned* bar, volatile LAS unsigned* st) {
    XcdBarrier b; b.bar = bar; b.x = xb_xcc_id(); b.st = st;
    if (threadIdx.x == 0) (void)xb_add(&bar[XB_XCNT(b.x)], 1u);
    return b;
}
DI void xcd_barrier_complete(unsigned* bar, unsigned x, unsigned& nloc, unsigned& nx) {
    const unsigned G = gridDim.x * gridDim.y * gridDim.z;
    unsigned sum, cnt, mine, sp = 0u;
    for (;;) {
        sum = 0u; cnt = 0u; mine = 0u;
#pragma unroll
        for (unsigned j = 0; j < 16; ++j) { const unsigned c = xb_ld(&bar[XB_XCNT(j)]); sum += c; cnt += (c > 0u) ? 1u : 0u; mine = (j == x) ? c : mine; }
        if (sum == G) break;
        __builtin_amdgcn_s_sleep(1);
        if ((++sp & 255u) == 0u) { if (xb_ld(&bar[XB_TMO])) break; if (sp > XB_SPIN_CAP) { atomicAdd(&bar[XB_TMO], 1u); break; } }
    }
    nloc = mine > 0u ? mine : 1u; nx = cnt > 0u ? cnt : 1u;
}
DI void xcd_barrier(const XcdBarrier& b) {
    asm volatile("s_waitcnt vmcnt(0)" ::: "memory");
    __syncthreads();
    if (threadIdx.x == 0) {
        unsigned* bar = b.bar;
        __builtin_amdgcn_s_waitcnt(0);
        unsigned nloc = b.st[0], nx = b.st[1];
        if (nloc == 0u) { xcd_barrier_complete(bar, b.x, nloc, nx); b.st[0] = nloc; b.st[1] = nx; }
        const unsigned old = xb_add(&bar[XB_XSUB(b.x)], 1u);
        const unsigned gen = old / nloc;
        if (old + 1u == (gen + 1u) * nloc) {
            __builtin_amdgcn_fence(__ATOMIC_RELEASE, "agent");
            asm volatile("s_waitcnt vmcnt(0)" ::: "memory");
            const unsigned og = xb_add(&bar[XB_TOP], 1u);
            const unsigned tg = og / nx;
            if (og + 1u == (tg + 1u) * nx) xb_add(&bar[XB_TOPGEN], 1u);
            else XB_SPIN(xb_ld(&bar[XB_TOPGEN]) == tg, bar);
            __builtin_amdgcn_fence(__ATOMIC_ACQUIRE, "agent");
            xb_add(&bar[XB_XGEN(b.x)], 1u);
            asm volatile("s_waitcnt vmcnt(0)" ::: "memory");
        } else {
            XB_SPIN(xb_ld(&bar[XB_XGEN(b.x)]) == gen, bar);
            __builtin_amdgcn_fence(__ATOMIC_ACQUIRE, "agent");
            asm volatile("s_waitcnt vmcnt(0)" ::: "memory");
        }
    }
    __syncthreads();
}

struct Args { const float* in[24]; float* out; unsigned char* ws; int ph_lo, ph_hi, sub, pad; };
struct Frame {
    LAS unsigned char* lds;
    int tid, lane, wave, G, bid;
    const float* const* in;
};

DI void transpose_item(const float* W, int src_ld, int src_col0, int k0, bf16* WT, int dst_ld, int dst_row0, LAS float* scr, int lane) {
#pragma unroll 8
    for (int i = 0; i < 32; ++i) { const int kk = 2 * i + (lane >> 5); scr[kk * 33 + (lane & 31)] = W[(size_t)(k0 + kk) * src_ld + src_col0 + (lane & 31)]; }
    asm volatile("s_waitcnt lgkmcnt(0)" ::: "memory");
    const int c = lane & 7;
#pragma unroll
    for (int j = 0; j < 4; ++j) { const int n = (lane >> 3) + 8 * j; const LAS float* s = scr + (8 * c) * 33 + n;
        v4u o; o.x = pk2(s[0 * 33], s[1 * 33]); o.y = pk2(s[2 * 33], s[3 * 33]); o.z = pk2(s[4 * 33], s[5 * 33]); o.w = pk2(s[6 * 33], s[7 * 33]);
        *(GAS v4u*)(WT + (size_t)(dst_row0 + n) * dst_ld + k0 + 8 * c) = o; }
    asm volatile("s_waitcnt lgkmcnt(0)" ::: "memory");
}
DI void rms_row_to_bf16(const float* xrow, const f32x4 (&wv)[8], bf16* orow, int lane) {
    GAS unsigned long long* o8 = (GAS unsigned long long*)orow + lane;
    if (!xrow) {
#pragma unroll
        for (int j = 0; j < 8; ++j) o8[64 * j] = 0ull;
        return; }
    const GAS f32x4* xr = (const GAS f32x4*)xrow + lane;
    f32x4 v[8]; float s = 0.f;
#pragma unroll
    for (int j = 0; j < 8; ++j) { v[j] = xr[64 * j]; s += (v[j].x * v[j].x + v[j].y * v[j].y) + (v[j].z * v[j].z + v[j].w * v[j].w); }
    const float rstd = 1.f / sqrtf(wave_sum(s) * (1.f / DM) + EPS);
#pragma unroll
    for (int j = 0; j < 8; ++j) { const f32x4 ww = wv[j];
        o8[64 * j] = (unsigned long long)pk2(v[j].x * rstd * ww.x, v[j].y * rstd * ww.y) | ((unsigned long long)pk2(v[j].z * rstd * ww.z, v[j].w * rstd * ww.w) << 32); }
}
DI const float* x_row(const Args& a, int r) {
    if (r < NMETA) return a.in[7] + (size_t)r * DM;
    if (r < NPOS) return a.in[0] + (size_t)(r - NMETA) * DM;
    if (r < ROW_S) return nullptr;
    if (r < ROW_S + NSAMP) return a.in[1] + (size_t)(r - ROW_S) * DM;
    return nullptr;
}
DI void p0_prologue(const Args& a, LAS unsigned char* lds, int gw, int NGW, int lane, int wave) {
    LAS float* scr = (LAS float*)(lds + wave * 16384);
    bf16* WIN = (bf16*)(a.ws + WS_WIN); bf16* WOUT = (bf16*)(a.ws + WS_WOUT); bf16* WBA = (bf16*)(a.ws + WS_WBA); bf16* XN = (bf16*)(a.ws + WS_XN);
    constexpr int I_IN = 32 * (NPROJ / 32), I_OUT = 32 * (DM / 32);
    for (int it = gw; it < I_IN + I_OUT; it += NGW) {
        if (it < I_IN) { const int kb = it / (NPROJ / 32), nb = it % (NPROJ / 32); const int n0 = 32 * nb;
            transpose_item(a.in[9], 5648, n0 + (n0 >= 4096 ? 16 : 0), 64 * kb, WIN, DM, n0, scr, lane); }
        else { const int r = it - I_IN; const int kb = r / (DM / 32), nb = r % (DM / 32); transpose_item(a.in[15], DM, 32 * nb, 64 * kb, WOUT, DM, 32 * nb, scr, lane); }
    }
    for (int e = gw * 64 + lane; e < 16 * DM; e += NGW * 64) { const int n = e / DM, k = e % DM; WBA[e] = (bf16)f2bf(a.in[9][(size_t)k * 5648 + 4096 + n]); }
    f32x4 wv[8];
#pragma unroll
    for (int j = 0; j < 8; ++j) wv[j] = ((const GAS f32x4*)a.in[16])[lane + 64 * j];
    for (int m = gw; m < MPAD; m += NGW) rms_row_to_bf16(x_row(a, m), wv, XN + (size_t)m * DM, lane);
}
DI void p5_ffn_weights(const Args& a, LAS unsigned char* lds, int gw, int NGW, int lane, int wave, int part) {
    LAS float* scr = (LAS float*)(lds + wave * 16384);
    bf16* WGU = (bf16*)(a.ws + WS_WGU); bf16* WDOWN = (bf16*)(a.ws + WS_WDOWN);
    constexpr int I_GU = 32 * (2 * DFF / 32), I_DN = (DFF / 64) * (DM / 32);
    for (int it = (part ? I_GU : 0) + gw; it < (part ? I_GU + I_DN : I_GU); it += NGW) {
        if (it < I_GU) { const int kb = it / (2 * DFF / 32), nb = it % (2 * DFF / 32); const int u = nb >> 3, bi = nb & 7;
            const float* src = bi < 4 ? a.in[20] : a.in[21];
            transpose_item(src, DFF, 128 * u + 32 * (bi & 3), 64 * kb, WGU, DM, 32 * nb, scr, lane); }
        else { const int r = it - I_GU; const int kb = r / (DM / 32), nb = r % (DM / 32); transpose_item(a.in[23], DM, 32 * nb, 64 * kb, WDOWN, DFF, 32 * nb, scr, lane); }
    }
}
constexpr int BA_RS = 4112, BA_AS = 528, BA_AOFF = 16 * BA_RS, BA_ABUF = 64 * BA_AS, BA_RED = BA_AOFF + 2 * BA_ABUF;
DI void p1_ba(const Args& a, LAS unsigned char* lds, int bid, int G, int tid, int lane, int wave) {
    const bf16* XN = (const bf16*)(a.ws + WS_XN); const bf16* WBA = (const bf16*)(a.ws + WS_WBA); float* BA = (float*)(a.ws + WS_BA);
    for (int e = tid; e < 16 * 256; e += NTHR) *(LAS v4u*)(lds + (e >> 8) * BA_RS + (e & 255) * 16) = *(const GAS v4u*)(WBA + (size_t)(e >> 8) * DM + (e & 255) * 8);
    const int r = lane & 15, q = lane >> 4, rs = wave & 3, kh = wave >> 2;
    for (int it = bid; it < MPAD / 64; it += G) {
        const bf16* A0 = XN + (size_t)64 * it * DM;
        v4u st[4][4];
#pragma unroll
        for (int c = 0; c < 4; ++c)
#pragma unroll
            for (int j = 0; j < 4; ++j) { const int e = tid + 512 * j; st[c][j] = *(const GAS v4u*)(A0 + (size_t)(e >> 5) * DM + 256 * c + (e & 31) * 8); }
        f32x4 acc = {0.f, 0.f, 0.f, 0.f};
#pragma unroll
        for (int c = 0; c < 8; ++c) {
#pragma unroll
            for (int j = 0; j < 4; ++j) { const int e = tid + 512 * j; *(LAS v4u*)(lds + BA_AOFF + (c & 1) * BA_ABUF + (e >> 5) * BA_AS + (e & 31) * 16) = st[c & 3][j]; }
            if (c + 4 < 8) {
#pragma unroll
                for (int j = 0; j < 4; ++j) { const int e = tid + 512 * j; st[c & 3][j] = *(const GAS v4u*)(A0 + (size_t)(e >> 5) * DM + 256 * (c + 4) + (e & 31) * 8); }
            }
            LDS_SYNC();
            const LAS unsigned char* ab = lds + BA_AOFF + (c & 1) * BA_ABUF + (16 * rs + r) * BA_AS + 16 * q + 256 * kh;
            const LAS unsigned char* bb = lds + r * BA_RS + 512 * c + 16 * q + 256 * kh;
#pragma unroll
            for (int s = 0; s < 4; ++s) acc = mfma16(*(const LAS bf16x8*)(ab + 64 * s), *(const LAS bf16x8*)(bb + 64 * s), acc);
        }
        LDS_SYNC();
        LAS f32x4* red = (LAS f32x4*)(lds + BA_RED);
        if (kh == 1) red[rs * 64 + lane] = acc;
        LDS_SYNC();
        if (kh == 0) { acc += red[rs * 64 + lane];
#pragma unroll
            for (int i = 0; i < 4; ++i) BA[(size_t)(64 * it + 16 * rs + 4 * q + i) * 16 + r] = acc[i]; }
        LDS_SYNC();
    }
}

struct EpiProj {
    static constexpr bool PERM = true;
    bf16* qkv; bf16* z; bf16* sqkv;
    DI void operator()(const f32x4 (&acc)[2][2][4][2], const pg8::Unit& u, int wr, int wc, int fr, int fq) const {
        bf16* base; int ldc, colt;
        if (u.pn < 12) { base = qkv; ldc = QKVD; colt = u.pn * 256; } else if (u.pn < 16) { base = z; ldc = 1024; colt = (u.pn - 12) * 256; } else { base = sqkv; ldc = SQKV_LD; colt = (u.pn - 16) * 256; }
        const int row0 = u.pm * 256 + wr * 64 + fr, col0 = colt + wc * 32 + 8 * fq;
#pragma unroll
        for (int ai = 0; ai < 2; ++ai)
#pragma unroll
            for (int m = 0; m < 4; ++m) { bf16* rowp = base + (size_t)(row0 + ai * 128 + m * 16) * ldc + col0;
#pragma unroll
                for (int bj = 0; bj < 2; ++bj) { const f32x4 v0 = acc[ai][bj][m][0], v1 = acc[ai][bj][m][1];
                    v4u w; w.x = pg8::cvt_pk_bf16(v0[0], v0[1]); w.y = pg8::cvt_pk_bf16(v0[2], v0[3]); w.z = pg8::cvt_pk_bf16(v1[0], v1[1]); w.w = pg8::cvt_pk_bf16(v1[2], v1[3]);
                    *(v4u*)(rowp + bj * 128) = w; } }
    }
};
struct EpiSplit {
    static constexpr bool PERM = true;
    bf16* O; int ldc; float* P; int row0, prow;
    DI void operator()(const f32x4 (&acc)[2][2][4][2], const pg8::Unit& u, int wr, int wc, int fr, int fq) const {
        const int rowb = u.pm * 256 + wr * 64 + fr, col0 = u.pn * 256 + wc * 32 + 8 * fq;
#pragma unroll
        for (int ai = 0; ai < 2; ++ai)
#pragma unroll
            for (int m = 0; m < 4; ++m) { const int row = rowb + ai * 128 + m * 16;
#pragma unroll
                for (int bj = 0; bj < 2; ++bj) { const f32x4 v0 = acc[ai][bj][m][0], v1 = acc[ai][bj][m][1];
                    if (u.sp < 0) { v4u w; w.x = pg8::cvt_pk_bf16(v0[0], v0[1]); w.y = pg8::cvt_pk_bf16(v0[2], v0[3]); w.z = pg8::cvt_pk_bf16(v1[0], v1[1]); w.w = pg8::cvt_pk_bf16(v1[2], v1[3]);
                        *(v4u*)(O + (size_t)row * ldc + col0 + bj * 128) = w; }
                    else { float* pp = P + ((size_t)u.sp * prow + (row - row0)) * ldc + col0 + bj * 128; *(f32x4*)pp = v0; *(f32x4*)(pp + 4) = v1; } } }
    }
};
struct EpiPlain {
    static constexpr bool PERM = true;
    bf16* O; int ldc;
    DI void operator()(const f32x4 (&acc)[2][2][4][2], const pg8::Unit& u, int wr, int wc, int fr, int fq) const {
        const int row0 = u.pm * 256 + wr * 64 + fr, col0 = u.pn * 256 + wc * 32 + 8 * fq;
#pragma unroll
        for (int ai = 0; ai < 2; ++ai)
#pragma unroll
            for (int m = 0; m < 4; ++m) { bf16* rowp = O + (size_t)(row0 + ai * 128 + m * 16) * ldc + col0;
#pragma unroll
                for (int bj = 0; bj < 2; ++bj) { const f32x4 v0 = acc[ai][bj][m][0], v1 = acc[ai][bj][m][1];
                    v4u w; w.x = pg8::cvt_pk_bf16(v0[0], v0[1]); w.y = pg8::cvt_pk_bf16(v0[2], v0[3]); w.z = pg8::cvt_pk_bf16(v1[0], v1[1]); w.w = pg8::cvt_pk_bf16(v1[2], v1[3]);
                    *(v4u*)(rowp + bj * 128) = w; } }
    }
};

constexpr int FFN_PT = 65, FFN_NM = 69;
struct AMapFfn {
    static constexpr int HSTEP_ROWS = 4;
    static __host__ __device__ __forceinline__ int row_in_half(int R) { return 128 * ((R >> 6) & 1) + 8 * (R & 15) + ((R >> 4) & 3); }
    static __host__ __device__ __forceinline__ long base_row(int pm) { return pm < FFN_PT ? (long)(NMETA + 254 * pm - 2) : (long)(ROW_S + 256 * (pm - FFN_PT)); }
};
struct EpiFfn {
    static constexpr bool PERM = true;
    bf16* act; const float* cw; const float* hist; float* out; LAS float* xch;
    DI void operator()(const f32x4 (&acc)[2][2][4][2], const pg8::Unit& u, int wr, int wc, int fr, int fq) const {
        const bool samp = u.pm >= FFN_PT;
        const int rho = 16 * wr + fr, colb = 128 * u.pn + 32 * wc + 8 * fq;
        const long row0 = AMapFfn::base_row(u.pm) + 8 * rho;
        if (wr == 0 && fr == 15) {
#pragma unroll
            for (int n = 0; n < 2; ++n)
#pragma unroll
                for (int e = 0; e < 4; ++e) { xch[(wc * 2 + 0) * 32 + 8 * fq + 4 * n + e] = acc[1][0][2][n][e]; xch[(wc * 2 + 1) * 32 + 8 * fq + 4 * n + e] = acc[1][0][3][n][e]; }
        }
        asm volatile("s_waitcnt lgkmcnt(0)" ::: "memory"); __builtin_amdgcn_s_barrier(); asm volatile("" ::: "memory");
        unsigned res[8][4]; float aprev[8];
        const bool tailt = !samp && u.pm == FFN_PT - 1;
        const int sb_ = 32 * (u.pm - FFN_PT) + rho;
#pragma unroll
        for (int n = 0; n < 2; ++n) {
            const int col4 = colb + 4 * n;
            const f32x4 w0v = *(const f32x4*)(cw + col4), w1v = *(const f32x4*)(cw + DFF + col4), w2v = *(const f32x4*)(cw + 2 * DFF + col4);
            f32x4 h0v = {0.f, 0.f, 0.f, 0.f}, h1v = {0.f, 0.f, 0.f, 0.f};
            if (samp) { h0v = *(const f32x4*)(hist + (size_t)(sb_ * 2 + 0) * DFF + col4); h1v = *(const f32x4*)(hist + (size_t)(sb_ * 2 + 1) * DFF + col4); }
            f32x4 g6v, g7v;
#pragma unroll
            for (int e = 0; e < 4; ++e) {
                const int col = col4 + e;
                const float w0 = w0v[e], w1 = w1v[e], w2 = w2v[e];
                float g[8], up[8];
#pragma unroll
                for (int j = 0; j < 8; ++j) { g[j] = acc[j >> 2][0][j & 3][n][e]; up[j] = acc[j >> 2][1][j & 3][n][e]; }
                float pm1 = __shfl_up(g[7], 1), pm2 = __shfl_up(g[6], 1);
                if (samp) { pm2 = h0v[e]; pm1 = h1v[e]; }
                else if (fr == 0) { if (wr == 1) { pm2 = xch[(wc * 2 + 0) * 32 + 8 * fq + 4 * n + e]; pm1 = xch[(wc * 2 + 1) * 32 + 8 * fq + 4 * n + e]; } else { pm1 = 0.f; pm2 = 0.f; } }
#pragma unroll
                for (int j = 0; j < 8; ++j) {
                    const float gm1 = j >= 1 ? g[j - 1] : pm1, gm2 = j >= 2 ? g[j - 2] : (j == 1 ? pm1 : pm2);
                    const float c = w0 * gm2 + w1 * gm1 + w2 * g[j];
                    const float a = siluf_(c) * up[j];
                    if ((e & 1) == 0) aprev[j] = a; else res[j][2 * n + (e >> 1)] = pk2(aprev[j], a);
                }
                g6v[e] = g[6]; g7v[e] = g[7];
                if (tailt) {
#pragma unroll
                    for (int j = 0; j < 8; ++j) { const long r = row0 + j; if (r == NPOS - 2) out[O_PFC + col] = g[j]; if (r == NPOS - 1) out[O_PFC + DFF + col] = g[j]; }
                }
            }
            if (samp) { *(f32x4*)(out + O_SFC + (size_t)(sb_ * 2 + 0) * DFF + col4) = g6v; *(f32x4*)(out + O_SFC + (size_t)(sb_ * 2 + 1) * DFF + col4) = g7v; }
        }
#pragma unroll
        for (int j = 0; j < 8; ++j) {
            const long r = row0 + j; const bool ok = samp ? true : ((8 * rho + j >= 2) && r < NPOS);
            if (ok) { v4u w; w.x = res[j][0]; w.y = res[j][1]; w.z = res[j][2]; w.w = res[j][3]; *(v4u*)(act + (size_t)r * DFF + colb) = w; }
        }
    }
};

DI float sumsq8(const f32x4 (&v)[8]) { float s = 0.f;
#pragma unroll
    for (int j = 0; j < 8; ++j) s += (v[j].x * v[j].x + v[j].y * v[j].y) + (v[j].z * v[j].z + v[j].w * v[j].w);
    return s; }
DI f32x4 bf4(v2u w) { return (f32x4){bflo(w.x), bfhi(w.x), bflo(w.y), bfhi(w.y)}; }
struct Row6 { f32x4 x[8]; v2u m[8]; };
DI void row6_load(Row6& r, const Args& a, int m, int lane) {
    const GAS f32x4* xr = (const GAS f32x4*)x_row(a, m) + lane; const GAS v2u* mr = (const GAS v2u*)((const bf16*)(a.ws + WS_MIXOUT) + (size_t)m * DM) + lane;
#pragma unroll
    for (int j = 0; j < 8; ++j) { r.x[j] = xr[64 * j]; r.m[j] = mr[64 * j]; }
}
DI void row6_finish(const f32x4 (&mv)[8], const f32x4 (&xv)[8], const f32x4 (&wp)[8], const f32x4 (&wf)[8], bf16* xn2row, bf16* h1row, int lane) {
    const float rstd = __builtin_amdgcn_rsqf(wave_sum(sumsq8(mv)) * (1.f / DM) + EPS);
    f32x4 hv[8];
#pragma unroll
    for (int j = 0; j < 8; ++j) hv[j] = xv[j] + mv[j] * rstd * wp[j];
    const float rstd2 = __builtin_amdgcn_rsqf(wave_sum(sumsq8(hv)) * (1.f / DM) + EPS);
    GAS v2u* h8 = (GAS v2u*)h1row + lane;
#pragma unroll
    for (int j = 0; j < 8; ++j) h8[64 * j] = (v2u){pk2(hv[j].x, hv[j].y), pk2(hv[j].z, hv[j].w)};
    GAS unsigned long long* o8 = (GAS unsigned long long*)xn2row + lane;
#pragma unroll
    for (int j = 0; j < 8; ++j) { const f32x4 ww = wf[j];
        o8[64 * j] = (unsigned long long)pk2(hv[j].x * rstd2 * ww.x, hv[j].y * rstd2 * ww.y) | ((unsigned long long)pk2(hv[j].z * rstd2 * ww.z, hv[j].w * rstd2 * ww.w) << 32); }
}
DI void p6_rows(const Args& a, int gw, int NGW, int lane) {
    bf16* XN2 = (bf16*)(a.ws + WS_XN); bf16* MO = (bf16*)(a.ws + WS_MIXOUT);
    f32x4 wp[8], wf[8];
#pragma unroll
    for (int j = 0; j < 8; ++j) { wp[j] = ((const GAS f32x4*)a.in[17])[lane + 64 * j]; wf[j] = ((const GAS f32x4*)a.in[18])[lane + 64 * j]; }
    {
        Row6 A, B; int m = gw;
        if (m < TAIL_ROW0) row6_load(A, a, m, lane);
        for (; m < TAIL_ROW0; m += 2 * NGW) {
            const int m1 = m + NGW, m2 = m + 2 * NGW;
            if (m1 < TAIL_ROW0) row6_load(B, a, m1, lane);
            { f32x4 mv[8];
#pragma unroll
              for (int j = 0; j < 8; ++j) mv[j] = bf4(A.m[j]);
              row6_finish(mv, A.x, wp, wf, XN2 + (size_t)m * DM, MO + (size_t)m * DM, lane); }
            if (m1 >= TAIL_ROW0) break;
            if (m2 < TAIL_ROW0) row6_load(A, a, m2, lane);
            { f32x4 mv[8];
#pragma unroll
              for (int j = 0; j < 8; ++j) mv[j] = bf4(B.m[j]);
              row6_finish(mv, B.x, wp, wf, XN2 + (size_t)m1 * DM, MO + (size_t)m1 * DM, lane); }
        }
    }
    for (int m = TAIL_ROW0 + gw; m < MPAD; m += NGW) {
        const float* xrow = x_row(a, m);
        if (!xrow) { GAS unsigned long long* o8 = (GAS unsigned long long*)(XN2 + (size_t)m * DM) + lane;
#pragma unroll
            for (int j = 0; j < 8; ++j) o8[64 * j] = 0ull;
            continue; }
        const GAS f32x4* xr = (const GAS f32x4*)xrow + lane;
        const GAS f32x4* pr = (const GAS f32x4*)((const float*)(a.ws + WS_PART) + (size_t)(m - TAIL_ROW0) * DM) + lane;
        f32x4 mv[8], xv[8];
#pragma unroll
        for (int j = 0; j < 8; ++j) { xv[j] = xr[64 * j]; mv[j] = pr[64 * j]; }
#pragma unroll 1
        for (int sp = 1; sp < NSPLIT; ++sp) {
#pragma unroll
            for (int j = 0; j < 8; ++j) mv[j] += pr[(size_t)sp * TAIL_ROWS * (DM / 4) + 64 * j]; }
        row6_finish(mv, xv, wp, wf, XN2 + (size_t)m * DM, MO + (size_t)m * DM, lane);
    }
}
struct Row9 { v2u h[8], y[8]; };
DI void row9_load(Row9& r, const Args& a, int i, int lane) {
    const GAS v2u* hr = (const GAS v2u*)((const bf16*)(a.ws + WS_MIXOUT) + (size_t)(NMETA + i) * DM) + lane; const GAS v2u* yr = (const GAS v2u*)((const bf16*)(a.ws + WS_XN) + (size_t)(NMETA + i) * DM) + lane;
#pragma unroll
    for (int j = 0; j < 8; ++j) { r.h[j] = hr[64 * j]; r.y[j] = yr[64 * j]; }
}
DI void row9_finish(const v2u (&hp)[8], const f32x4 (&yv)[8], const f32x4 (&wq)[8], float* orow, int lane) {
    const float rstd2 = __builtin_amdgcn_rsqf(wave_sum(sumsq8(yv)) * (1.f / DM) + EPS);
    GAS f32x4* o4 = (GAS f32x4*)orow + lane;
#pragma unroll
    for (int j = 0; j < 8; ++j) o4[64 * j] = bf4(hp[j]) + yv[j] * rstd2 * wq[j];
}
DI void p9_rows(const Args& a, LAS unsigned char* lds, int tid, int gw, int NGW, int lane) {
    f32x4 wq[8];
#pragma unroll
    for (int j = 0; j < 8; ++j) wq[j] = ((const GAS f32x4*)a.in[19])[lane + 64 * j];
    constexpr int NMAIN = TAIL_ROW0 - NMETA;
    {
        Row9 A, B; int i = gw;
        if (i < NMAIN) row9_load(A, a, i, lane);
        for (; i < NMAIN; i += 2 * NGW) {
            const int i1 = i + NGW, i2 = i + 2 * NGW;
            if (i1 < NMAIN) row9_load(B, a, i1, lane);
            { f32x4 yv[8];
#pragma unroll
              for (int j = 0; j < 8; ++j) yv[j] = bf4(A.y[j]);
              row9_finish(A.h, yv, wq, a.out + O_YP + (size_t)i * DM, lane); }
            if (i1 >= NMAIN) break;
            if (i2 < NMAIN) row9_load(A, a, i2, lane);
            { f32x4 yv[8];
#pragma unroll
              for (int j = 0; j < 8; ++j) yv[j] = bf4(B.y[j]);
              row9_finish(B.h, yv, wq, a.out + O_YP + (size_t)i1 * DM, lane); }
        }
    }
    const bf16* MO = (const bf16*)(a.ws + WS_MIXOUT);
    for (int i = NMAIN + gw; i < SEQ + NSAMP; i += NGW) {
        const int m = i < SEQ ? NMETA + i : ROW_S + (i - SEQ);
        float* orow = i < SEQ ? a.out + O_YP + (size_t)i * DM : a.out + O_YS + (size_t)(i - SEQ) * DM;
        const GAS v2u* hr = (const GAS v2u*)(MO + (size_t)m * DM) + lane;
        const GAS f32x4* pr = (const GAS f32x4*)((const float*)(a.ws + WS_PART) + (size_t)(m - TAIL_ROW0) * DM) + lane;
        v2u hp[8]; f32x4 yv[8];
#pragma unroll
        for (int j = 0; j < 8; ++j) { hp[j] = hr[64 * j]; yv[j] = pr[64 * j]; }
#pragma unroll 1
        for (int sp = 1; sp < NSPLIT; ++sp) {
#pragma unroll
            for (int j = 0; j < 8; ++j) yv[j] += pr[(size_t)sp * TAIL_ROWS * (DM / 4) + 64 * j]; }
        row9_finish(hp, yv, wq, orow, lane);
    }
}

constexpr int L_KN = 0, L_QN = 17408, L_KB = 34816, L_VBT = 52224, L_KBGT = 70656, L_KDT = 89088, L_AM = 107520, L_TL = 124928, L_GC = 134144, L_RED = 134656  ;
constexpr int RS = 136;
constexpr int TS = 72;
constexpr int AS = 68;
constexpr int RAWS = 392;
DI int perm64(int t) { return (t & 32) + 8 * ((t >> 2) & 3) + 4 * ((t >> 4) & 1) + (t & 3); }
DI float wave_incl_scan(float v, int lane) {
#pragma unroll
    for (int o = 1; o < 64; o <<= 1) { const float n = __shfl_up(v, o); if (lane >= o) v += n; }
    return v;
}
struct PrepIn { v4u rv[7]; float wv[3]; float bb, aa; };
DI void prep_fetch(PrepIn& p, const Args& a, int item, int tid, int lane) {
    const int h = item / NCH, c = item % NCH, r0 = CH * c;
    const bf16* QKV = (const bf16*)(a.ws + WS_QKV); const float* BA = (const float*)(a.ws + WS_BA);
    const int cc = tid % 48, rb = tid / 48;
    const bf16* gsrc = QKV + (long)(r0 - 3 + rb) * QKVD + (cc >> 4) * GW + h * HD + (cc & 15) * 8;
#pragma unroll
    for (int i = 0; i < 7; ++i) { p.rv[i] = (v4u){0u, 0u, 0u, 0u};
        if (tid < 480 && rb + 10 * i < 67 && r0 - 3 + rb + 10 * i >= 0) p.rv[i] = *(const GAS v4u*)(gsrc + (long)(10 * i) * QKVD); }
#pragma unroll
    for (int i = 0; i < 3; ++i) { const int e = tid + 512 * i, tap = e / 384, ch = e % 384; p.wv[i] = a.in[10][(size_t)tap * QKVD + (ch >> 7) * GW + h * HD + (ch & 127)]; }
    const int row = r0 + lane; p.bb = 0.f; p.aa = 0.f;
    if (row < NPOS) { p.bb = BA[(size_t)row * 16 + h]; p.aa = BA[(size_t)row * 16 + 8 + h]; }
}
DI void gdn_prep_item(const Args& a, LAS unsigned char* lds, int item, int next_item, PrepIn& pin, int tid_in, int lane_in, int wave) {
    int tid = tid_in, lane = lane_in; asm volatile("" : "+v"(tid), "+v"(lane));
    const int h = item / NCH, c = item % NCH, r0 = CH * c;
    const bf16* QKV = (const bf16*)(a.ws + WS_QKV); const float* BA = (const float*)(a.ws + WS_BA);
    const bool dry = (a.sub & 512) != 0; const int stop = (a.sub >> 10) & 15;
    unsigned char* si = dry ? a.ws + 500 * MiB + (size_t)(item % 256) * SCANIN_ITEM : a.ws + WS_SCANIN + (size_t)item * SCANIN_ITEM;
    LAS bf16* KN = (LAS bf16*)(lds + L_KN); LAS bf16* QN = (LAS bf16*)(lds + L_QN); LAS bf16* KB = (LAS bf16*)(lds + L_KB);
    LAS bf16* VBT = (LAS bf16*)(lds + L_VBT); LAS bf16* KBGT = (LAS bf16*)(lds + L_KBGT); LAS bf16* KDT = (LAS bf16*)(lds + L_KDT);
    LAS float* AM = (LAS float*)(lds + L_AM); LAS bf16* TL = (LAS bf16*)(lds + L_TL); LAS float* GC = (LAS float*)(lds + L_GC); LAS float* RED = (LAS float*)(lds + L_RED);
    const int t = lane, row = r0 + t; const bool valid = row < NPOS;
    float beta = 0.f, g = 0.f;
    if (valid) { beta = sigmoidf_(pin.bb); g = -__expf(a.in[11][h]) * softplusf_(pin.aa + a.in[12][h]); }
    const float gc = wave_incl_scan(g, lane);
    const float gcl = __shfl(gc, 63);
    if (wave == 0) { GC[t] = gc; if (lane == 0 && !dry) ((float*)(a.ws + WS_GL))[item] = __expf(gcl); }
    {
        LAS bf16* RAW = (LAS bf16*)lds; LAS float* WCV = (LAS float*)(lds + L_AM);
        const int cc = tid % 48, rb = tid / 48;
#pragma unroll
        for (int i = 0; i < 7; ++i) { if (tid < 480 && rb + 10 * i < 67) *(LAS v4u*)(RAW + (rb + 10 * i) * RAWS + cc * 8) = pin.rv[i]; }
#pragma unroll
        for (int i = 0; i < 3; ++i) WCV[tid + 512 * i] = pin.wv[i];
    }
    if (next_item >= 0) prep_fetch(pin, a, next_item, tid, lane);
    LDS_SYNC();
    if (dry && stop == 1) return;
    float qv[16], kv[16], vv[16];
    {
        const LAS bf16* RAW = (const LAS bf16*)lds; const LAS float* WCV = (const LAS float*)(lds + L_AM);
        const int d0 = 16 * wave;
#pragma unroll
        for (int part = 0; part < 3; ++part) {
            float acc[16];
#pragma unroll
            for (int j = 0; j < 16; ++j) acc[j] = 0.f;
#pragma unroll 2
            for (int i = 0; i < 4; ++i) {
                const v4u x0 = *(const LAS v4u*)(RAW + (t + i) * RAWS + part * 128 + d0), x1 = *(const LAS v4u*)(RAW + (t + i) * RAWS + part * 128 + d0 + 8);
                const LAS f32x4* w4 = (const LAS f32x4*)(WCV + i * 384 + part * 128 + d0);
                const f32x4 wa = w4[0], wb = w4[1], wc = w4[2], wd = w4[3];
                const float w[16] = {wa[0], wa[1], wa[2], wa[3], wb[0], wb[1], wb[2], wb[3], wc[0], wc[1], wc[2], wc[3], wd[0], wd[1], wd[2], wd[3]};
                const unsigned xs[8] = {x0.x, x0.y, x0.z, x0.w, x1.x, x1.y, x1.z, x1.w};
#pragma unroll
                for (int j = 0; j < 8; ++j) { acc[2 * j] += w[2 * j] * bflo(xs[j]); acc[2 * j + 1] += w[2 * j + 1] * bfhi(xs[j]); }
            }
#pragma unroll
            for (int j = 0; j < 16; ++j) { const float s = siluf_(acc[j]); if (part == 0) qv[j] = s; else if (part == 1) kv[j] = s; else vv[j] = s; }
        }
        float sq = 0.f, sk = 0.f;
#pragma unroll
        for (int j = 0; j < 16; ++j) { sq += qv[j] * qv[j]; sk += kv[j] * kv[j]; }
        RED[wave * 64 + t] = sq; RED[512 + wave * 64 + t] = sk;
    }
    LDS_SYNC();
    if (dry && stop == 2) return;
    {
        float sq = 0.f, sk = 0.f;
#pragma unroll
        for (int w = 0; w < 8; ++w) { sq += RED[w * 64 + t]; sk += RED[512 + w * 64 + t]; }
        const float rq = 1.f / sqrtf(sq + EPS) * 0.08838834764831845f, rk = 1.f / sqrtf(sk + EPS);
        const float eg = __expf(gc), ekd = __expf(gcl - gc);
        const int d0 = 16 * wave, pt = perm64(t);
        unsigned wq[8], wk[8], wb[8];
#pragma unroll
        for (int j = 0; j < 8; ++j) { const float k0 = kv[2 * j] * rk, k1 = kv[2 * j + 1] * rk;
            wq[j] = pk2(qv[2 * j] * rq, qv[2 * j + 1] * rq); wk[j] = pk2(k0, k1); wb[j] = pk2(k0 * beta, k1 * beta); }
        *(LAS v4u*)(QN + t * RS + d0) = (v4u){wq[0], wq[1], wq[2], wq[3]}; *(LAS v4u*)(QN + t * RS + d0 + 8) = (v4u){wq[4], wq[5], wq[6], wq[7]};
        *(LAS v4u*)(KN + t * RS + d0) = (v4u){wk[0], wk[1], wk[2], wk[3]}; *(LAS v4u*)(KN + t * RS + d0 + 8) = (v4u){wk[4], wk[5], wk[6], wk[7]};
        *(LAS v4u*)(KB + t * RS + d0) = (v4u){wb[0], wb[1], wb[2], wb[3]}; *(LAS v4u*)(KB + t * RS + d0 + 8) = (v4u){wb[4], wb[5], wb[6], wb[7]};
#pragma unroll
        for (int j = 0; j < 16; ++j) { const float kn = kv[j] * rk;
            VBT[(d0 + j) * TS + t] = (bf16)f2bf(vv[j] * beta); KBGT[(d0 + j) * TS + t] = (bf16)f2bf(kn * beta * eg); KDT[(d0 + j) * TS + pt] = (bf16)f2bf(kn * ekd); }
    }
    LDS_SYNC();
    if (dry && stop == 3) return;
    const int r = lane & 15, q = lane >> 4;
    {
        int tmt[3], tnt[3]; bool isl[3]; f32x4 acc[3]; bf16x8 af[3][4], bfr[3][4];
#pragma unroll
        for (int k = 0; k < 3; ++k) {
            const int idx = (wave + 8 * k < 20) ? wave + 8 * k : wave; isl[k] = idx < 10;
            int a_ = 0, b_ = isl[k] ? idx : idx - 10; while (b_ >= a_ + 1) { b_ -= a_ + 1; ++a_; }
            tmt[k] = isl[k] ? a_ : b_; tnt[k] = isl[k] ? b_ : a_;
            const LAS bf16* pa = (isl[k] ? KB : KN) + (16 * tmt[k] + r) * RS + 8 * q; const LAS bf16* pb = (isl[k] ? KN : QN) + (16 * tnt[k] + r) * RS + 8 * q;
#pragma unroll
            for (int s = 0; s < 4; ++s) { af[k][s] = *(const LAS bf16x8*)(pa + 32 * s); bfr[k][s] = *(const LAS bf16x8*)(pb + 32 * s); }
            acc[k] = (f32x4){0.f, 0.f, 0.f, 0.f};
        }
#pragma unroll
        for (int s = 0; s < 4; ++s)
#pragma unroll
            for (int k = 0; k < 3; ++k) acc[k] = mfma16(af[k][s], bfr[k][s], acc[k]);
#pragma unroll
        for (int k = 0; k < 3; ++k) {
            if (k == 2 && wave >= 4) break;
            const int cn = 16 * tnt[k] + r; const float gn = GC[cn];
            if (isl[k]) {
#pragma unroll
                for (int e = 0; e < 4; ++e) { const int i = 16 * tmt[k] + 4 * q + e; AM[i * AS + cn] = i > cn ? acc[k][e] * __expf(GC[i] - gn) : 0.f; }
            } else {
                float o[4];
#pragma unroll
                for (int e = 0; e < 4; ++e) { const int ck = 16 * tmt[k] + 4 * q + e; o[e] = cn >= ck ? acc[k][e] * __expf(gn - GC[ck]) : 0.f; }
                *(GAS v2u*)((bf16*)(si + SI_QK) + cn * 64 + 32 * (tmt[k] >> 1) + 8 * q + 4 * (tmt[k] & 1)) = (v2u){pk2(o[0], o[1]), pk2(o[2], o[3])};
            }
        }
        if (wave >= 4) {
            v2u lo[4], hi[4]; float eg[4];
#pragma unroll
            for (int k = 0; k < 4; ++k) { const int e = tid - 256 + 256 * k, cq = e >> 4, s = (e >> 2) & 3, qq = e & 3;
                lo[k] = *(const LAS v2u*)(QN + cq * RS + 32 * s + 4 * qq); hi[k] = *(const LAS v2u*)(QN + cq * RS + 32 * s + 16 + 4 * qq); eg[k] = GC[cq]; }
#pragma unroll
            for (int k = 0; k < 4; ++k) { const int e = tid - 256 + 256 * k, cq = e >> 4, s = (e >> 2) & 3, qq = e & 3; const float g_ = __expf(eg[k]);
                v4u o; o.x = pk2(bflo(lo[k].x) * g_, bfhi(lo[k].x) * g_); o.y = pk2(bflo(lo[k].y) * g_, bfhi(lo[k].y) * g_); o.z = pk2(bflo(hi[k].x) * g_, bfhi(hi[k].x) * g_); o.w = pk2(bflo(hi[k].y) * g_, bfhi(hi[k].y) * g_);
                *(GAS v4u*)((bf16*)(si + SI_QG) + cq * 128 + 32 * s + 8 * qq) = o; }
            for (int z = wave - 4; z < 6; z += 4) {
                const int mt = z == 0 ? 1 : (z < 3 ? 2 : 3), nt = z == 0 ? 0 : (z < 3 ? z - 1 : z - 3);
                *(GAS v2u*)((bf16*)(si + SI_QK) + (16 * nt + r) * 64 + 32 * (mt >> 1) + 8 * q + 4 * (mt & 1)) = (v2u){0u, 0u};
            }
        }
    }
    LDS_SYNC();
    if (dry && stop == 4) return;
    LAS float* TF = (LAS float*)(lds + L_KN); LAS float* XF = (LAS float*)(lds + L_KB);
    if (wave < 3) {
        const int e = wave * 64 + lane, n = e & 15, p = (e >> 4) - 4;
        const bool diag = e < 64, act = e < 160;
        const int bi = diag ? (e >> 4) : (p == 0 ? 1 : (p < 3 ? 2 : 3)), bk = diag ? bi : (p == 0 ? 0 : (p < 3 ? p - 1 : p - 3));
        if (act) {
            const LAS float* arow = AM + (16 * bi) * AS + 16 * bi; const LAS float* rhs = AM + (16 * bi) * AS + 16 * bk + n;
            LAS float* dst = (diag ? TF : XF) + (16 * bi) * AS + 16 * bk + n;
            float rv[16];
#pragma unroll
            for (int i = 0; i < 16; ++i) rv[i] = diag ? (i == n ? 1.f : 0.f) : -rhs[i * AS];
            float t[16];
#pragma unroll
            for (int i = 0; i < 16; ++i) t[i] = 0.f;
#pragma unroll
            for (int i = 0; i < 16; ++i) {
                float a0 = rv[i], a1 = 0.f, a2 = 0.f, a3 = 0.f;
#pragma unroll
                for (int jc = 0; jc < (i + 3) / 4; ++jc) { const f32x4 av = *(const LAS f32x4*)(arow + i * AS + 4 * jc);
                    a0 -= av[0] * t[4 * jc]; a1 -= av[1] * t[4 * jc + 1]; a2 -= av[2] * t[4 * jc + 2]; a3 -= av[3] * t[4 * jc + 3]; }
                t[i] = (a0 + a1) + (a2 + a3);
                dst[i * AS] = t[i];
                if (diag) TL[(16 * bi + i) * TS + 16 * bi + n] = (bf16)f2bf(t[i]);
            }
        }
    } else {
        v4u kd[4];
#pragma unroll
        for (int k = 0; k < 4; ++k) { const int e = tid - 192 + 320 * k, ec = e < 1024 ? e : 1023; kd[k] = *(const LAS v4u*)(KDT + (ec >> 3) * TS + 8 * (ec & 7)); }
#pragma unroll
        for (int k = 0; k < 4; ++k) { const int e = tid - 192 + 320 * k; if (e < 1024) *(GAS v4u*)((bf16*)(si + SI_KD) + (e >> 3) * 64 + 8 * (e & 7)) = kd[k]; }
    }
    LDS_SYNC();
    if (dry && stop == 5) return;
#pragma unroll
    for (int d = 1; d < 4; ++d) {
        const int nbk = 4 - d;
        for (int e = tid; e < 256 * nbk; e += NTHR) {
            const int b_ = e >> 8, m_ = (e >> 4) & 15, n_ = e & 15, i_ = d + b_, j_ = b_; float x0 = 0.f, x1 = 0.f;
            const LAS float* br = XF + (16 * i_ + m_) * AS + 16 * j_; const LAS float* tc = TF + (16 * j_) * AS + 16 * j_ + n_;
#pragma unroll
            for (int kk = 0; kk < 16 * d; kk += 4) { const f32x4 bv = *(const LAS f32x4*)(br + kk);
                x0 += bv[0] * tc[kk * AS] + bv[1] * tc[(kk + 1) * AS]; x1 += bv[2] * tc[(kk + 2) * AS] + bv[3] * tc[(kk + 3) * AS]; }
            const float x = x0 + x1;
            TF[(16 * i_ + m_) * AS + 16 * j_ + n_] = x; TL[(16 * i_ + m_) * TS + 16 * j_ + n_] = (bf16)f2bf(x);
        }
        LDS_SYNC();
    }
    if (dry && stop == 6) return;
    {
        const int ntw = wave & 3, m0 = 4 * (wave >> 2);
        bf16x8 tl[4][2], vb[2], kb[4][2], tb[2];
#pragma unroll
        for (int s = 0; s < 2; ++s) {
            vb[s] = *(const LAS bf16x8*)(VBT + (16 * wave + r) * TS + 32 * s + 8 * q); tb[s] = *(const LAS bf16x8*)(TL + (16 * ntw + r) * TS + 32 * s + 8 * q);
#pragma unroll
            for (int m = 0; m < 4; ++m) { tl[m][s] = *(const LAS bf16x8*)(TL + (16 * m + r) * TS + 32 * s + 8 * q); kb[m][s] = *(const LAS bf16x8*)(KBGT + (16 * (m0 + m) + r) * TS + 32 * s + 8 * q); }
        }
        f32x4 au[4], aw[4];
#pragma unroll
        for (int m = 0; m < 4; ++m) { au[m] = (f32x4){0.f, 0.f, 0.f, 0.f}; aw[m] = (f32x4){0.f, 0.f, 0.f, 0.f}; }
#pragma unroll
        for (int s = 0; s < 2; ++s)
#pragma unroll
            for (int m = 0; m < 4; ++m) { au[m] = mfma16(tl[m][s], vb[s], au[m]); aw[m] = mfma16(kb[m][s], tb[s], aw[m]); }
        bf16* ub = (bf16*)(si + SI_U) + (wave * 64 + lane) * 16;
        *(GAS v4u*)ub = (v4u){pk2(au[0][0], au[0][1]), pk2(au[0][2], au[0][3]), pk2(au[1][0], au[1][1]), pk2(au[1][2], au[1][3])};
        *(GAS v4u*)(ub + 8) = (v4u){pk2(au[2][0], au[2][1]), pk2(au[2][2], au[2][3]), pk2(au[3][0], au[3][1]), pk2(au[3][2], au[3][3])};
        bf16* wb = (bf16*)(si + SI_W) + (16 * ntw + r) * 128 + 8 * q + 32 * (m0 >> 1);
        *(GAS v4u*)wb = (v4u){pk2(-aw[0][0], -aw[0][1]), pk2(-aw[0][2], -aw[0][3]), pk2(-aw[1][0], -aw[1][1]), pk2(-aw[1][2], -aw[1][3])};
        *(GAS v4u*)(wb + 32) = (v4u){pk2(-aw[2][0], -aw[2][1]), pk2(-aw[2][2], -aw[2][3]), pk2(-aw[3][0], -aw[3][1]), pk2(-aw[3][2], -aw[3][3])};
    }
    LDS_SYNC();
}

constexpr int SCAN_SL = 2;
constexpr int SC_WS = 272, SC_KS = 144, SC_KOFF = 64 * SC_WS, SC_UOFF = SC_KOFF + 128 * SC_KS, SC_BUF = SC_UOFF + SCAN_SL * 2048;
constexpr int SC_OUT = 2 * SC_BUF, SC_OBUF = SCAN_SL * 6144, SC_GL = SC_OUT + 2 * SC_OBUF;
struct ScanSet { v4u r[9]; };
DI void scan_issue(ScanSet& s, const unsigned char* si, int lid, int dvs0, const unsigned char* pf, unsigned& pfd) {
#pragma unroll
    for (int j = 0; j < 9; ++j) {
        const unsigned char* p = j < 4 ? si + SI_W + (lid + 256 * j) * 16 : (j < 8 ? si + SI_KD + (lid + 256 * (j - 4)) * 16 : si + SI_U + dvs0 * 2048 + lid * 16);
        asm volatile("global_load_dwordx4 %0, %1, off" : "=v"(s.r[j]) : "v"(p) : "memory");
    }
    asm volatile("global_load_dword %0, %1, off" : "+v"(pfd) : "v"(pf) : "memory");
}
DI void scan_wait_put(ScanSet& s, LAS unsigned char* buf, int lid) {
    asm volatile("s_waitcnt vmcnt(31)" : "+v"(s.r[0]), "+v"(s.r[1]), "+v"(s.r[2]), "+v"(s.r[3]), "+v"(s.r[4]), "+v"(s.r[5]), "+v"(s.r[6]), "+v"(s.r[7]), "+v"(s.r[8]) :: "memory");
#pragma unroll
    for (int j = 0; j < 4; ++j) { const int e = lid + 256 * j; *(LAS v4u*)(buf + (e >> 4) * SC_WS + (e & 15) * 16) = s.r[j]; }
#pragma unroll
    for (int j = 4; j < 8; ++j) { const int e = lid + 256 * (j - 4); *(LAS v4u*)(buf + SC_KOFF + (e >> 3) * SC_KS + (e & 7) * 16) = s.r[j]; }
    *(LAS v4u*)(buf + SC_UOFF + lid * 16) = s.r[8];
}
DI void scan_step(f32x4 (&S)[8], LAS unsigned char* buf, LAS unsigned char* ob, float gl, int dvl, int lane) {
    const int r = lane & 15, q = lane >> 4;
    const int woff = r * SC_WS + 16 * q, koff = SC_KOFF + r * SC_KS + 16 * q;
    const v4u ua = *(const LAS v4u*)(buf + SC_UOFF + (dvl * 64 + lane) * 32), ub = *(const LAS v4u*)(buf + SC_UOFF + (dvl * 64 + lane) * 32 + 16);
    bf16x8 Wf[4][4], Kf[8][2];
#pragma unroll
    for (int s = 0; s < 4; ++s)
#pragma unroll
        for (int m = 0; m < 4; ++m) Wf[m][s] = *(const LAS bf16x8*)(buf + woff + 16 * m * SC_WS + 64 * s);
#pragma unroll
    for (int s = 0; s < 2; ++s)
#pragma unroll
        for (int m = 0; m < 8; ++m) Kf[m][s] = *(const LAS bf16x8*)(buf + koff + 16 * m * SC_KS + 64 * s);
    bf16x8 Sb[4];
#pragma unroll
    for (int s = 0; s < 4; ++s) Sb[s] = pack8(S[2 * s][0], S[2 * s][1], S[2 * s][2], S[2 * s][3], S[2 * s + 1][0], S[2 * s + 1][1], S[2 * s + 1][2], S[2 * s + 1][3]);
    f32x4 vn[4];
    vn[0] = (f32x4){bflo(ua.x), bfhi(ua.x), bflo(ua.y), bfhi(ua.y)}; vn[1] = (f32x4){bflo(ua.z), bfhi(ua.z), bflo(ua.w), bfhi(ua.w)};
    vn[2] = (f32x4){bflo(ub.x), bfhi(ub.x), bflo(ub.y), bfhi(ub.y)}; vn[3] = (f32x4){bflo(ub.z), bfhi(ub.z), bflo(ub.w), bfhi(ub.w)};
#pragma unroll
    for (int s = 0; s < 4; ++s)
#pragma unroll
        for (int m = 0; m < 4; ++m) vn[m] = mfma16(Wf[m][s], Sb[s], vn[m]);
#pragma unroll
    for (int m = 0; m < 8; ++m) S[m] = S[m] * gl;
    bf16x8 Vb[2];
#pragma unroll
    for (int s = 0; s < 2; ++s) Vb[s] = pack8(vn[2 * s][0], vn[2 * s][1], vn[2 * s][2], vn[2 * s][3], vn[2 * s + 1][0], vn[2 * s + 1][1], vn[2 * s + 1][2], vn[2 * s + 1][3]);
#pragma unroll
    for (int s = 0; s < 2; ++s)
#pragma unroll
        for (int m = 0; m < 8; ++m) S[m] = mfma16(Kf[m][s], Vb[s], S[m]);
    LAS unsigned char* o = ob + dvl * 6144 + lane * 16;
#pragma unroll
    for (int s = 0; s < 4; ++s) *(LAS bf16x8*)(o + s * 1024) = Sb[s];
#pragma unroll
    for (int s = 0; s < 2; ++s) *(LAS bf16x8*)(o + (4 + s) * 1024) = Vb[s];
}
DI void scan_store(const LAS unsigned char* ob, unsigned char* g, int sid) {
#pragma unroll
    for (int k = 0; k < SC_OBUF / 2048; ++k) *(GAS v4u*)(g + (sid + 128 * k) * 16) = *(const LAS v4u*)(ob + (sid + 128 * k) * 16);
}
#define SCAN_SYNC() do { asm volatile("s_waitcnt lgkmcnt(0)" ::: "memory"); __builtin_amdgcn_s_barrier(); asm volatile("" ::: "memory"); } while (0)
DI void gdn_scan(const Args& a, LAS unsigned char* lds, int sb, int wave, int tid, int lane) {
    const int h = sb % NH, dvs0 = (sb / NH) * SCAN_SL;
    const bool comp = wave < SCAN_SL, loader = wave >= 2 && wave < 6, storer = wave >= 6;
    const int lid = (wave - 2) * 64 + lane, sid = (wave - 6) * 64 + lane;
    const float* GL = (const float*)(a.ws + WS_GL) + h * NCH;
    const bool dry = (a.sub & 256) != 0;
    const int cmask = dry ? 3 : 0x7fffffff;
    const unsigned char* si0 = a.ws + WS_SCANIN + (size_t)h * NCH * SCANIN_ITEM;
    unsigned char* so0 = (dry ? a.ws + 500 * MiB : a.ws + WS_SCANOUT + (size_t)h * NCH * SCANOUT_ITEM) + (size_t)dvs0 * 6144;
    LAS float* GLs = (LAS float*)(lds + SC_GL);
    for (int i = tid; i < NCH; i += NTHR) GLs[i] = GL[i];
    asm volatile("s_waitcnt vmcnt(0)" ::: "memory");
    if (loader) {
        ScanSet A, B, C, D; unsigned pfd = 0u;
        const int pfo = lid < 64 ? (sb / NH) * 8192 + lid * 128 : (lid < 96 ? (int)SI_U + dvs0 * 2048 + (lid - 64) * 128 : (sb / NH) * 8192);
#define SCAN_PF(c) (si0 + (size_t)(((c) + 7 < NCH ? (c) + 7 : NCH - 1) & cmask) * SCANIN_ITEM + pfo)
        scan_issue(A, si0, lid, dvs0, SCAN_PF(-3), pfd); scan_issue(B, si0 + SCANIN_ITEM, lid, dvs0, SCAN_PF(-2), pfd); scan_issue(C, si0 + 2 * SCANIN_ITEM, lid, dvs0, SCAN_PF(-1), pfd); scan_issue(D, si0 + 3 * SCANIN_ITEM, lid, dvs0, SCAN_PF(0), pfd);
        scan_wait_put(A, lds, lid);
        SCAN_SYNC();
#define SCAN_LD(c, SETL, SETW) do { if ((c) < NCH) { const int cl_ = (c) + 4 < NCH ? (c) + 4 : NCH - 1; scan_issue(SETL, si0 + (size_t)(cl_ & cmask) * SCANIN_ITEM, lid, dvs0, SCAN_PF((c) + 1), pfd); \
        scan_wait_put(SETW, lds + (((c) + 1) & 1) * SC_BUF, lid); SCAN_SYNC(); } } while (0)
        for (int c = 0; c < NCH; c += 4) { SCAN_LD(c, A, B); SCAN_LD(c + 1, B, C); SCAN_LD(c + 2, C, D); SCAN_LD(c + 3, D, A); }
#undef SCAN_LD
#undef SCAN_PF
        asm volatile("s_waitcnt vmcnt(0)" : "+v"(A.r[0]), "+v"(B.r[0]), "+v"(C.r[0]), "+v"(D.r[0]), "+v"(pfd) :: "memory");
    } else if (comp) {
        const int r = lane & 15, q = lane >> 4;
        f32x4 S[8];
#pragma unroll
        for (int m = 0; m < 8; ++m) S[m] = (f32x4){0.f, 0.f, 0.f, 0.f};
        SCAN_SYNC();
        for (int c = 0; c < NCH; ++c) { scan_step(S, lds + (c & 1) * SC_BUF, lds + SC_OUT + (c & 1) * SC_OBUF, GLs[c], wave, lane); SCAN_SYNC(); }
        float* out = a.out + O_PGS + (size_t)h * HD * HD; const int dvs = dvs0 + wave;
        if (!dry) {
#pragma unroll
        for (int m = 0; m < 8; ++m)
#pragma unroll
            for (int e = 0; e < 4; ++e) out[(16 * m + 4 * q + e) * HD + 16 * dvs + r] = S[m][e];
        }
    } else {
        SCAN_SYNC();
        for (int c = 0; c < NCH; ++c) { if (storer && c > 0) scan_store(lds + SC_OUT + ((c - 1) & 1) * SC_OBUF, so0 + (size_t)((c - 1) & cmask) * SCANOUT_ITEM, sid); SCAN_SYNC(); }
        if (storer) scan_store(lds + SC_OUT + ((NCH - 1) & 1) * SC_OBUF, so0 + (size_t)((NCH - 1) & cmask) * SCANOUT_ITEM, sid);
    }
}

constexpr int O_QGS = 272, O_QKS = 144, O_ZS = 272;
constexpr int O_QG = 0, O_QK = 64 * O_QGS, O_Z = O_QK + 64 * O_QKS, O_IN = O_Z + 64 * O_ZS;
constexpr int O_OT = 2 * O_IN, O_PART = O_OT + 64 * 272;
struct OutStage { v4u g0, g1, k0, z0, z1; v4u sb[4], vb[2]; };
DI void out_load(OutStage& s, const Args& a, int item, int tid, int lane, int dvs) {
    const int h = item / NCH, c = item % NCH;
    const unsigned char* si = a.ws + WS_SCANIN + (size_t)item * SCANIN_ITEM;
    const unsigned char* so = a.ws + WS_SCANOUT + (size_t)item * SCANOUT_ITEM + (size_t)dvs * 6144;
    const bf16* Z = (const bf16*)(a.ws + WS_Z) + (size_t)CH * c * 1024 + h * HD;
    s.g0 = *(const GAS v4u*)(si + SI_QG + tid * 16); s.g1 = *(const GAS v4u*)(si + SI_QG + (tid + 512) * 16);
    s.k0 = *(const GAS v4u*)(si + SI_QK + tid * 16);
    s.z0 = *(const GAS v4u*)(Z + (size_t)(tid >> 4) * 1024 + (tid & 15) * 8); s.z1 = *(const GAS v4u*)(Z + (size_t)(32 + (tid >> 4)) * 1024 + (tid & 15) * 8);
#pragma unroll
    for (int i = 0; i < 4; ++i) s.sb[i] = *(const GAS v4u*)(so + (i * 64 + lane) * 16);
#pragma unroll
    for (int i = 0; i < 2; ++i) s.vb[i] = *(const GAS v4u*)(so + ((4 + i) * 64 + lane) * 16);
}
DI void out_put(const OutStage& s, LAS unsigned char* buf, int tid) {
    *(LAS v4u*)(buf + O_QG + (tid >> 4) * O_QGS + (tid & 15) * 16) = s.g0; *(LAS v4u*)(buf + O_QG + (32 + (tid >> 4)) * O_QGS + (tid & 15) * 16) = s.g1;
    *(LAS v4u*)(buf + O_QK + (tid >> 3) * O_QKS + (tid & 7) * 16) = s.k0;
    *(LAS v4u*)(buf + O_Z + (tid >> 4) * O_ZS + (tid & 15) * 16) = s.z0; *(LAS v4u*)(buf + O_Z + (32 + (tid >> 4)) * O_ZS + (tid & 15) * 16) = s.z1;
}
DI void out_item(const Args& a, LAS unsigned char* lds, LAS unsigned char* buf, LAS unsigned char* nbuf, const OutStage& cur, const OutStage& nxt, int item, int tid, int lane, int wave) {
    const int h = item / NCH, c = item % NCH, r = lane & 15, q = lane >> 4, dvs = wave;
    LAS float* PART = (LAS float*)(lds + O_PART);
    f32x4 o[4]; float ss[4][4];
    {
        bf16x8 Gf[4][4], Qf[4][2];
#pragma unroll
        for (int s = 0; s < 4; ++s)
#pragma unroll
            for (int m = 0; m < 4; ++m) Gf[m][s] = *(const LAS bf16x8*)(buf + O_QG + (16 * m + r) * O_QGS + 64 * s + 16 * q);
#pragma unroll
        for (int s = 0; s < 2; ++s)
#pragma unroll
            for (int m = 0; m < 4; ++m) Qf[m][s] = *(const LAS bf16x8*)(buf + O_QK + (16 * m + r) * O_QKS + 64 * s + 16 * q);
#pragma unroll
        for (int m = 0; m < 4; ++m) o[m] = (f32x4){0.f, 0.f, 0.f, 0.f};
#pragma unroll
        for (int s = 0; s < 4; ++s)
#pragma unroll
            for (int m = 0; m < 4; ++m) o[m] = mfma16(Gf[m][s], __builtin_bit_cast(bf16x8, cur.sb[s]), o[m]);
#pragma unroll
        for (int s = 0; s < 2; ++s)
#pragma unroll
            for (int m = 0; m < 4; ++m) o[m] = mfma16(Qf[m][s], __builtin_bit_cast(bf16x8, cur.vb[s]), o[m]);
    }
#pragma unroll
    for (int m = 0; m < 4; ++m)
#pragma unroll
        for (int e = 0; e < 4; ++e) ss[m][e] = o[m][e] * o[m][e];
#pragma unroll
    for (int st_ = 1; st_ < 16; st_ <<= 1)
#pragma unroll
        for (int m = 0; m < 4; ++m)
#pragma unroll
            for (int e = 0; e < 4; ++e) ss[m][e] += __shfl_xor(ss[m][e], st_);
    if (r == 0) {
#pragma unroll
        for (int m = 0; m < 4; ++m)
#pragma unroll
            for (int e = 0; e < 4; ++e) PART[wave * 64 + 16 * m + 4 * q + e] = ss[m][e]; }
    LDS_SYNC();
    const int dv = 16 * dvs + r; const float nw = a.in[13][dv];
#pragma unroll
    for (int m = 0; m < 4; ++m)
#pragma unroll
        for (int e = 0; e < 4; ++e) { const int tk = 16 * m + 4 * q + e; float tot = 0.f;
#pragma unroll
            for (int w = 0; w < 8; ++w) tot += PART[w * 64 + tk];
            const float rstd = __builtin_amdgcn_rsqf(tot * (1.f / HD) + EPS);
            const float z = bf2f(*(const LAS bf16*)(buf + O_Z + tk * O_ZS + dv * 2));
            *(LAS bf16*)(lds + O_OT + tk * 272 + dv * 2) = (bf16)f2bf(o[m][e] * rstd * nw * siluf_(z)); }
    out_put(nxt, nbuf, tid);
    LDS_SYNC();
    bf16* MIX = (bf16*)(a.ws + WS_XN) + (size_t)CH * c * DM + h * HD;
    *(GAS v4u*)(MIX + (size_t)(tid >> 4) * DM + (tid & 15) * 8) = *(const LAS v4u*)(lds + O_OT + (tid >> 4) * 272 + (tid & 15) * 16);
    *(GAS v4u*)(MIX + (size_t)(32 + (tid >> 4)) * DM + (tid & 15) * 8) = *(const LAS v4u*)(lds + O_OT + (32 + (tid >> 4)) * 272 + (tid & 15) * 16);
}
DI void gdn_out_phase(const Args& a, LAS unsigned char* lds, int bid, int G, int tid, int lane, int wave) {
    constexpr int NIT = NH * NCH;
    if (bid >= NIT) return;
    OutStage A, B;
    out_load(A, a, bid, tid, lane, wave);
    out_put(A, lds, tid);
    LDS_SYNC();
    for (int it = bid; it < NIT; it += 2 * G) {
        const int n1 = it + G, n2 = it + 2 * G;
        out_load(B, a, n1 < NIT ? n1 : it, tid, lane, wave);
        out_item(a, lds, lds, lds + O_IN, A, B, it, tid, lane, wave);
        if (n1 >= NIT) break;
        out_load(A, a, n2 < NIT ? n2 : n1, tid, lane, wave);
        out_item(a, lds, lds + O_IN, lds, B, A, n1, tid, lane, wave);
    }
    LDS_SYNC();
}

constexpr int S_QS = 0, S_KS = 1024, S_VS = 2048, S_US = 3072, S_WS = 4096, S_KK = 5120, S_QK = 5184, S_GC = 5248, S_BE = 5256, S_RED = 5264, S_SSQ = S_RED + 8192, S_END = S_SSQ + 32;
DI void gdn_sample_item(const Args& a, LAS unsigned char* lds, int item, int tid_in, int lane_in, int wave) {
    int tid = tid_in, lane = lane_in; asm volatile("" : "+v"(tid), "+v"(lane));
    const int b = item >> 3, h = item & 7, R0 = ROW_S + 8 * b;
    LAS float* L = (LAS float*)lds;
    const bf16* QKV = (const bf16*)(a.ws + WS_QKV); const float* BA = (const float*)(a.ws + WS_BA);
    const float* hist = a.in[4] + (size_t)b * 3 * QKVD;
    const int dv = tid & 127, part = tid >> 7;
    const float* S0 = a.in[5] + ((size_t)(b * NH + h) * HD) * HD;
    float s0[32];
#pragma unroll
    for (int k = 0; k < 32; ++k) s0[k] = S0[(size_t)(32 * part + k) * HD + dv];
    float zv[8];
#pragma unroll
    for (int i = 0; i < 8; ++i) zv[i] = part == 0 ? bf2f(((const bf16*)(a.ws + WS_Z))[(size_t)(R0 + i) * 1024 + h * HD + dv]) : 0.f;
    if (tid < 8) {
        const float bb = BA[(size_t)(R0 + tid) * 16 + h], aa = BA[(size_t)(R0 + tid) * 16 + 8 + h];
        L[S_BE + tid] = sigmoidf_(bb); L[S_GC + tid] = -__expf(a.in[11][h]) * softplusf_(aa + a.in[12][h]);
    }
    {
        const int t = wave; float vals[6];
#pragma unroll
        for (int p = 0; p < 6; ++p) {
            const int part = p >> 1, d = lane + 64 * (p & 1), ch = part * GW + h * HD + d; float acc = 0.f;
#pragma unroll
            for (int i = 0; i < 4; ++i) { const int tt = t - 3 + i;
                const float x = tt < 0 ? hist[(size_t)(3 + tt) * QKVD + ch] : bf2f(QKV[(size_t)(R0 + tt) * QKVD + ch]);
                acc += a.in[10][(size_t)i * QKVD + ch] * x; }
            vals[p] = siluf_(acc);
            if (t >= 5) a.out[O_SGC + ((size_t)b * 3 + (t - 5)) * QKVD + ch] = bf2f(QKV[(size_t)(R0 + t) * QKVD + ch]);
        }
        const float sq = wave_sum(vals[0] * vals[0] + vals[1] * vals[1]), sk = wave_sum(vals[2] * vals[2] + vals[3] * vals[3]);
        const float rq = 1.f / sqrtf(sq + EPS) * 0.08838834764831845f, rk = 1.f / sqrtf(sk + EPS);
        L[S_QS + t * 128 + lane] = vals[0] * rq; L[S_QS + t * 128 + lane + 64] = vals[1] * rq;
        L[S_KS + t * 128 + lane] = vals[2] * rk; L[S_KS + t * 128 + lane + 64] = vals[3] * rk;
        L[S_VS + t * 128 + lane] = vals[4]; L[S_VS + t * 128 + lane + 64] = vals[5];
    }
    LDS_SYNC();
    if (tid == 0) { float s = 0.f; for (int i = 0; i < 8; ++i) { s += L[S_GC + i]; L[S_GC + i] = s; } }
    {
        const int p = tid >> 2, qd = tid & 3, i = (p & 63) >> 3, j = p & 7;
        const LAS float* x = L + (p < 64 ? S_KS : S_QS) + i * 128 + 32 * qd; const LAS float* y = L + S_KS + j * 128 + 32 * qd; float s = 0.f;
#pragma unroll
        for (int d = 0; d < 32; d += 4) { const f32x4 xa = *(const LAS f32x4*)(x + d), ya = *(const LAS f32x4*)(y + d); s += (xa[0] * ya[0] + xa[1] * ya[1]) + (xa[2] * ya[2] + xa[3] * ya[3]); }
        s += __shfl_xor(s, 1); s += __shfl_xor(s, 2);
        if (qd == 0) L[(p < 64 ? S_KK : S_QK) + (p & 63)] = s;
    }
    LDS_SYNC();
    if (tid < 256) {
        const int col = tid & 127; const bool isw = tid >= 128; float sol[8];
#pragma unroll
        for (int i = 0; i < 8; ++i) {
            const float bi = L[S_BE + i], gi = L[S_GC + i];
            float v = isw ? bi * __expf(gi) * L[S_KS + i * 128 + col] : bi * L[S_VS + i * 128 + col];
#pragma unroll
            for (int j = 0; j < i; ++j) v -= bi * L[S_KK + i * 8 + j] * __expf(gi - L[S_GC + j]) * sol[j];
            sol[i] = v; L[(isw ? S_WS : S_US) + i * 128 + col] = v;
        }
    }
    LDS_SYNC();
    {
        float pv[8], po[8];
#pragma unroll
        for (int i = 0; i < 8; ++i) { pv[i] = 0.f; po[i] = 0.f; }
#pragma unroll
        for (int k = 0; k < 32; k += 4) {
#pragma unroll
            for (int i = 0; i < 8; ++i) { const f32x4 w4 = *(const LAS f32x4*)(L + S_WS + i * 128 + 32 * part + k), q4 = *(const LAS f32x4*)(L + S_QS + i * 128 + 32 * part + k);
                pv[i] += (w4[0] * s0[k] + w4[1] * s0[k + 1]) + (w4[2] * s0[k + 2] + w4[3] * s0[k + 3]); po[i] += (q4[0] * s0[k] + q4[1] * s0[k + 1]) + (q4[2] * s0[k + 2] + q4[3] * s0[k + 3]); } }
#pragma unroll
        for (int i = 0; i < 8; ++i) { L[S_RED + (part * 16 + i) * 128 + dv] = pv[i]; L[S_RED + (part * 16 + 8 + i) * 128 + dv] = po[i]; }
    }
    LDS_SYNC();
    float vnew[8], o[8];
    const float gl7 = L[S_GC + 7];
#pragma unroll
    for (int i = 0; i < 8; ++i) {
        float sv = 0.f, so = 0.f;
#pragma unroll
        for (int p = 0; p < 4; ++p) { sv += L[S_RED + (p * 16 + i) * 128 + dv]; so += L[S_RED + (p * 16 + 8 + i) * 128 + dv]; }
        vnew[i] = L[S_US + i * 128 + dv] - sv;
        const float gi = L[S_GC + i];
        float oo = so * __expf(gi);
#pragma unroll
        for (int j = 0; j <= i; ++j) oo += L[S_QK + i * 8 + j] * __expf(gi - L[S_GC + j]) * vnew[j];
        o[i] = oo;
    }
    {
        float* Sout = a.out + O_SGS + ((size_t)(b * NH + h) * HD) * HD;
        const float egl = __expf(gl7);
        float vd[8];
#pragma unroll
        for (int i = 0; i < 8; ++i) vd[i] = __expf(gl7 - L[S_GC + i]) * vnew[i];
#pragma unroll
        for (int k = 0; k < 32; k += 4) { f32x4 s4 = {s0[k] * egl, s0[k + 1] * egl, s0[k + 2] * egl, s0[k + 3] * egl};
#pragma unroll
            for (int i = 0; i < 8; ++i) s4 += *(const LAS f32x4*)(L + S_KS + i * 128 + 32 * part + k) * vd[i];
#pragma unroll
            for (int j = 0; j < 4; ++j) Sout[(size_t)(32 * part + k + j) * HD + dv] = s4[j]; }
    }
    if (part == 0) {
#pragma unroll
        for (int i = 0; i < 8; ++i) { const float s = wave_sum(o[i] * o[i]); if (lane == 0) L[S_SSQ + wave * 8 + i] = s; }
    }
    LDS_SYNC();
    if (part == 0) {
        bf16* MIX = (bf16*)(a.ws + WS_XN); const float nw = a.in[13][dv];
#pragma unroll
        for (int i = 0; i < 8; ++i) { const float rstd = 1.f / sqrtf((L[S_SSQ + i] + L[S_SSQ + 8 + i]) * (1.f / HD) + EPS);
            const size_t row = (size_t)R0 + i; const float z = zv[i];
            MIX[row * DM + h * HD + dv] = (bf16)f2bf(o[i] * rstd * nw * siluf_(z)); }
    }
    LDS_SYNC();
}

DI void vt_item(const Args& a, LAS unsigned char* lds, int blk, int tid) {
    const bf16* SQ = (const bf16*)(a.ws + WS_SQKV); bf16* VT = (bf16*)(a.ws + WS_VT);
    LAS bf16* T = (LAS bf16*)lds;
    const int p0 = 64 * blk;
    { const int rr = tid >> 3, cc = tid & 7;
        const GAS v4u* src = (const GAS v4u*)(SQ + (size_t)(p0 + rr) * SQKV_LD + 1280 + 32 * cc);
#pragma unroll
        for (int i = 0; i < 4; ++i) *(LAS v4u*)(T + rr * 264 + 32 * cc + 8 * i) = src[i]; }
    LDS_SYNC();
    { const int ch = tid >> 1, hf = tid & 1;
        unsigned w[16];
#pragma unroll
        for (int i = 0; i < 16; ++i) w[i] = (unsigned)T[(32 * hf + 2 * i) * 264 + ch] | ((unsigned)T[(32 * hf + 2 * i + 1) * 264 + ch] << 16);
        GAS v4u* dst = (GAS v4u*)(VT + (size_t)ch * VT_LD + p0 + 32 * hf);
#pragma unroll
        for (int i = 0; i < 4; ++i) dst[i] = (v4u){w[4 * i], w[4 * i + 1], w[4 * i + 2], w[4 * i + 3]}; }
    LDS_SYNC();
}
DI void kv_outputs(const Args& a, size_t gt, size_t NGT) {
    const bf16* SQ = (const bf16*)(a.ws + WS_SQKV); const bf16* QKV = (const bf16*)(a.ws + WS_QKV);
    for (size_t e = gt; e < 16 * 512; e += NGT) { const int pos = (int)(e >> 9), kv = (int)(e >> 8) & 1, c = (int)(e & 255);
        a.out[O_PMETA + e] = bf2f(SQ[(size_t)pos * SQKV_LD + 1024 + 256 * kv + c]); }
    for (size_t e = gt; e < 128 * 512; e += NGT) { const int pos = NPOS - 128 + (int)(e >> 9), kv = (int)(e >> 8) & 1, c = (int)(e & 255);
        a.out[O_PWIN + e] = bf2f(SQ[(size_t)pos * SQKV_LD + 1024 + 256 * kv + c]); }
    for (size_t e = gt; e < 3 * QKVD; e += NGT) { const int i = (int)(e / QKVD), c = (int)(e % QKVD);
        a.out[O_PGC + e] = bf2f(QKV[(size_t)(NPOS - 3 + i) * QKVD + c]); }
}
DI void swin_output(const Args& a, size_t gt, size_t NGT) {
    const bf16* SQ = (const bf16*)(a.ws + WS_SQKV);
    for (size_t e = gt; e < (size_t)DBATCH * 128 * 512 / 4; e += NGT) {
        const size_t e4 = e * 4; const int b = (int)(e4 >> 16), j = (int)(e4 >> 9) & 127, kv = (int)(e4 >> 8) & 1, c = (int)(e4 & 255);
        f32x4 v;
        if (j < 120) v = *(const GAS f32x4*)(a.in[3] + ((size_t)b * 128 + j + 8) * 512 + 256 * kv + c);
        else { const v2u w = *(const GAS v2u*)(SQ + (size_t)(ROW_S + 8 * b + (j - 120)) * SQKV_LD + 1024 + 256 * kv + c); v = (f32x4){bflo(w.x), bfhi(w.x), bflo(w.y), bfhi(w.y)}; }
        *(GAS f32x4*)(a.out + O_SWIN + e4) = v;
    }
}

DI int crow(int reg, int hh) { return (reg & 3) + 8 * (reg >> 2) + 4 * hh; }
constexpr int PK_RS = 272, PV_RS = 72;
constexpr int P_KOFF = 0, P_VOFF = 64 * PK_RS, P_BUF = P_VOFF + 256 * PV_RS;
struct SwaStage { v4u k[2], v[2]; };
DI void swa_stage_load(SwaStage& s, const bf16* SQ, const bf16* VT, int k0, int tid) {
#pragma unroll
    for (int j = 0; j < 2; ++j) { const int e = tid + 512 * j;
        s.k[j] = *(const GAS v4u*)(SQ + (size_t)(k0 + ((e >> 4) & 31)) * SQKV_LD + 1024 + (e >> 9) * HD + 8 * (e & 15));
        s.v[j] = *(const GAS v4u*)(VT + (size_t)((e >> 9) * HD + ((e >> 2) & 127)) * VT_LD + k0 + 8 * (e & 3)); }
}
DI void swa_stage_put(const SwaStage& s, LAS unsigned char* buf, int tid) {
#pragma unroll
    for (int j = 0; j < 2; ++j) { const int e = tid + 512 * j;
        *(LAS v4u*)(buf + P_KOFF + ((e >> 9) * 32 + ((e >> 4) & 31)) * PK_RS + 16 * (e & 15)) = s.k[j];
        LAS unsigned char* vp = buf + P_VOFF + ((e >> 9) * HD + ((e >> 2) & 127)) * PV_RS + 16 * (e & 3);
        *(LAS v2u*)vp = (v2u){s.v[j].x, s.v[j].y}; *(LAS v2u*)(vp + 8) = (v2u){s.v[j].z, s.v[j].w}; }
}
DI void swa_prompt_block(const Args& a, LAS unsigned char* lds, LAS float* btab  , const LAS int* bucket, int qt, int tid, int lane, int wave) {
    const bf16* SQ = (const bf16*)(a.ws + WS_SQKV); const bf16* VT = (const bf16*)(a.ws + WS_VT); bf16* MIX = (bf16*)(a.ws + WS_XN);
    const int head = wave, kvh = head >> 2, p0 = 32 * qt, ql = lane & 31, hh = lane >> 5, qpos = p0 + ql;
    for (int d = lane; d < 129; d += 64) btab[d] = a.in[8][(d < 128 ? bucket[d] : 31) * NH + head];
    bf16x8 Qf[8];
#pragma unroll
    for (int s = 0; s < 8; ++s) Qf[s] = *(const GAS bf16x8*)(SQ + (size_t)qpos * SQKV_LD + head * HD + 64 * hh + 8 * s);
    const float sink = a.in[14][head];
    float m = sink, l = hh == 0 ? 1.f : 0.f;
    f32x16 O[4];
#pragma unroll
    for (int mt = 0; mt < 4; ++mt)
#pragma unroll
        for (int e = 0; e < 16; ++e) O[mt][e] = 0.f;
    const float scale = 0.08838834764831845f;
    const int t1 = p0 >= 128 ? 1 : 1 + (128 - p0) / 32;
    SwaStage st;
    swa_stage_load(st, SQ, VT, 0, tid);
    swa_stage_put(st, lds, tid);
    LDS_SYNC();
    int par = 0;
    for (int ti = 0; ti < 6; ti = (ti == 0 ? t1 : ti + 1)) {
        const int k0 = ti == 0 ? 0 : p0 - 128 + 32 * (ti - 1);
        const int tn = ti == 0 ? t1 : ti + 1, k0n = tn < 6 ? p0 - 128 + 32 * (tn - 1) : k0;
        swa_stage_load(st, SQ, VT, k0n, tid);
        const LAS unsigned char* buf = lds + par * P_BUF;
        const LAS unsigned char* kb = buf + P_KOFF + (kvh * 32 + ql) * PK_RS + 128 * hh;
        f32x16 St;
#pragma unroll
        for (int e = 0; e < 16; ++e) St[e] = 0.f;
#pragma unroll
        for (int s = 0; s < 8; ++s) St = mfma32(*(const LAS bf16x8*)(kb + 16 * s), Qf[s], St);
        float sc[16]; float mx = -INFINITY;
#pragma unroll
        for (int e = 0; e < 16; ++e) { const int kpos = k0 + crow(e, hh), dist = qpos - kpos;
            const bool ok = ti == 0 ? (kpos < NMETA && dist >= 0) : (kpos >= NMETA && dist >= 0 && dist < WIN);
            const float bias = btab[dist < 0 ? 0 : (dist > 128 ? 128 : dist)];
            sc[e] = ok ? St[e] * scale + bias : -INFINITY; mx = fmaxf(mx, sc[e]); }
        mx = fmaxf(mx, __shfl_xor(mx, 32));
        const float mn = fmaxf(m, mx), alpha = __expf(m - mn); m = mn;
        float ps = 0.f; float p[16];
#pragma unroll
        for (int e = 0; e < 16; ++e) { p[e] = __expf(sc[e] - mn); ps += p[e]; }
        l = l * alpha + ps;
#pragma unroll
        for (int mt = 0; mt < 4; ++mt)
#pragma unroll
            for (int e = 0; e < 16; ++e) O[mt][e] *= alpha;
        bf16x8 Pb[2];
#pragma unroll
        for (int s = 0; s < 2; ++s) Pb[s] = pack8(p[8 * s], p[8 * s + 1], p[8 * s + 2], p[8 * s + 3], p[8 * s + 4], p[8 * s + 5], p[8 * s + 6], p[8 * s + 7]);
#pragma unroll
        for (int mt = 0; mt < 4; ++mt)
#pragma unroll
            for (int s = 0; s < 2; ++s) {
                const LAS unsigned char* vp = buf + P_VOFF + (kvh * HD + 32 * mt + ql) * PV_RS + 32 * s + 8 * hh;
                const v2u lo = *(const LAS v2u*)vp, hi = *(const LAS v2u*)(vp + 16);
                const v4u vv = {lo.x, lo.y, hi.x, hi.y};
                O[mt] = mfma32(__builtin_bit_cast(bf16x8, vv), Pb[s], O[mt]);
            }
        swa_stage_put(st, lds + (par ^ 1) * P_BUF, tid);
        par ^= 1;
        LDS_SYNC();
    }
    l += __shfl_xor(l, 32);
    const float inv = 1.f / l;
    LAS unsigned char* ow = lds + wave * (32 * 272);
#pragma unroll
    for (int mt = 0; mt < 4; ++mt)
#pragma unroll
        for (int g = 0; g < 4; ++g) *(LAS v2u*)(ow + ql * 272 + (32 * mt + 8 * g + 4 * hh) * 2) = (v2u){pk2(O[mt][4 * g] * inv, O[mt][4 * g + 1] * inv), pk2(O[mt][4 * g + 2] * inv, O[mt][4 * g + 3] * inv)};
    asm volatile("s_waitcnt lgkmcnt(0)" ::: "memory");
#pragma unroll
    for (int j = 0; j < 8; ++j) { const int e = lane + 64 * j, rr = e >> 4, cc = e & 15;
        if (p0 + rr < NPOS) *(GAS v4u*)(MIX + (size_t)(p0 + rr) * DM + GW + head * HD + 8 * cc) = *(const LAS v4u*)(ow + rr * 272 + 16 * cc); }
    LDS_SYNC();
}

constexpr int A_QS = 0, A_KV = 32 * 132, A_PS = A_KV + 152 * 132, A_END = A_PS + 32 * 160;
DI void swa_sample_item(const Args& a, LAS unsigned char* lds, const LAS int* bucket, int item, int tid_in, int lane_in, int wave) {
    int tid = tid_in, lane = lane_in; asm volatile("" : "+v"(tid), "+v"(lane));
    const int b = item >> 1, kvh = item & 1, R0 = ROW_S + 8 * b;
    LAS float* L = (LAS float*)lds;
    const bf16* SQ = (const bf16*)(a.ws + WS_SQKV); bf16* MIX = (bf16*)(a.ws + WS_XN);
    { const int qi = tid >> 4, pc = tid & 15, g = qi >> 3, t = qi & 7;
        const v4u w = *(const GAS v4u*)(SQ + (size_t)(R0 + t) * SQKV_LD + (kvh * 4 + g) * HD + 8 * pc);
        LAS float* d = L + A_QS + qi * 132 + 8 * pc;
        *(LAS f32x4*)d = (f32x4){bflo(w.x), bfhi(w.x), bflo(w.y), bfhi(w.y)}; *(LAS f32x4*)(d + 4) = (f32x4){bflo(w.z), bfhi(w.z), bflo(w.w), bfhi(w.w)}; }
#define SWA_FETCH_KV(kvr, which) { \
    _Pragma("unroll") for (int i = 0; i < 10; ++i) { const int e = tid + 512 * i, key = e >> 5, c4 = (e & 31) * 4; kvr[i] = (f32x4){0.f, 0.f, 0.f, 0.f}; \
        if (key < 16) kvr[i] = *(const GAS f32x4*)(a.in[2] + (((size_t)b * 16 + key) * 2 + (which)) * 256 + kvh * HD + c4); \
        else if (key < 144) kvr[i] = *(const GAS f32x4*)(a.in[3] + (((size_t)b * 128 + key - 16) * 2 + (which)) * 256 + kvh * HD + c4); \
        else if (key < 152) { const v2u w = *(const GAS v2u*)(SQ + (size_t)(R0 + key - 144) * SQKV_LD + 1024 + 256 * (which) + kvh * HD + c4); kvr[i] = (f32x4){bflo(w.x), bfhi(w.x), bflo(w.y), bfhi(w.y)}; } } }
#define SWA_PUT_KV(kvr) { _Pragma("unroll") for (int i = 0; i < 10; ++i) { const int e = tid + 512 * i, key = e >> 5, c4 = (e & 31) * 4; if (key < 152) *(LAS f32x4*)(L + A_KV + key * 132 + c4) = kvr[i]; } }
    f32x4 kreg[10], vreg[10];
    SWA_FETCH_KV(kreg, 0)
    SWA_PUT_KV(kreg)
    SWA_FETCH_KV(vreg, 1)
    LDS_SYNC();
    {
        const int qi = tid & 31, kg = tid >> 5, g = qi >> 3, t = qi & 7, head = kvh * 4 + g;
        for (int key = kg; key < 152; key += 16) {
            float s = 0.f;
#pragma unroll 8
            for (int d = 0; d < 128; d += 4) { const f32x4 x = *(const LAS f32x4*)(L + A_QS + qi * 132 + d), y = *(const LAS f32x4*)(L + A_KV + key * 132 + d); s += (x[0] * y[0] + x[1] * y[1]) + (x[2] * y[2] + x[3] * y[3]); }
            bool ok; int bk;
            if (key < 16) { ok = true; bk = 31; }
            else if (key < 144) { const int j = key - 16; ok = j > t; const int dist = 128 + t - j; bk = dist >= 128 ? 31 : bucket[dist]; }
            else { const int t2 = key - 144; ok = t2 <= t; bk = bucket[t - t2 < 0 ? 0 : t - t2]; }
            L[A_PS + qi * 160 + key] = ok ? s * 0.08838834764831845f + a.in[8][bk * NH + head] : -INFINITY;
        }
    }
    LDS_SYNC();
    {
        for (int rr = 0; rr < 4; ++rr) { const int qi = 4 * wave + rr, head = kvh * 4 + (qi >> 3); const float sink = a.in[14][head];
            float v0 = L[A_PS + qi * 160 + lane], v1 = L[A_PS + qi * 160 + 64 + lane], v2 = lane < 24 ? L[A_PS + qi * 160 + 128 + lane] : -INFINITY;
            float mx = fmaxf(fmaxf(v0, v1), fmaxf(v2, sink));
#pragma unroll
            for (int o = 1; o < 64; o <<= 1) mx = fmaxf(mx, __shfl_xor(mx, o));
            const float e0 = __expf(v0 - mx), e1 = __expf(v1 - mx), e2 = lane < 24 ? __expf(v2 - mx) : 0.f;
            const float den = wave_sum(e0 + e1 + e2) + __expf(sink - mx), inv = 1.f / den;
            L[A_PS + qi * 160 + lane] = e0 * inv; L[A_PS + qi * 160 + 64 + lane] = e1 * inv; if (lane < 24) L[A_PS + qi * 160 + 128 + lane] = e2 * inv; }
    }
    LDS_SYNC();
    SWA_PUT_KV(vreg)
    LDS_SYNC();
    {
        const int d = tid & 127, qg = tid >> 7; float o[8];
#pragma unroll
        for (int i = 0; i < 8; ++i) o[i] = 0.f;
        for (int key = 0; key < 152; ++key) { const float v = L[A_KV + key * 132 + d];
#pragma unroll
            for (int i = 0; i < 8; ++i) o[i] += L[A_PS + (8 * qg + i) * 160 + key] * v; }
#pragma unroll
        for (int i = 0; i < 8; ++i) { const int qi = 8 * qg + i, g = qi >> 3, t = qi & 7; MIX[(size_t)(R0 + t) * DM + GW + (kvh * 4 + g) * HD + d] = (bf16)f2bf(o[i]); }
    }
    LDS_SYNC();
#undef SWA_FETCH_KV
#undef SWA_PUT_KV
}

#ifndef MK_PER_PHASE
#define MK_PER_PHASE 0
#endif
constexpr int N_PHASES = 10;
constexpr int L_BUCKET = 139264, L_BTAB = 139776;


__global__ void __launch_bounds__(NTHR, 2) mega_fwd(Args args) {
    extern __shared__ __attribute__((aligned(16))) unsigned char lds_raw[];
    LAS unsigned char* lds = (LAS unsigned char*)lds_raw;
    const int tid = threadIdx.x, lane = tid & 63, wave = __builtin_amdgcn_readfirstlane(tid >> 6);
    const int G = gridDim.x, bid = blockIdx.x;
    const int gw = bid * NWAVES + wave, NGW = G * NWAVES;
    volatile LAS unsigned* MISC = (volatile LAS unsigned*)(lds + MISC_OFF);
    for (int u = tid; u < 64; u += NTHR) MISC[u] = 0u;
    __syncthreads();
    XcdBarrier bar; bar.bar = (unsigned*)(args.ws + WS_CTL) + CW_BAR; bar.x = 0; bar.st = nullptr;
    if (!MK_PER_PHASE) bar = xcd_barrier_post((unsigned*)(args.ws + WS_CTL) + CW_BAR, MISC + 8);
    const int lo = args.ph_lo, hi = args.ph_hi;
#ifndef PH_MASK
#define PH_MASK 0x3ff
#endif
#define IN(k) (((PH_MASK >> (k)) & 1) && lo <= (k) && (k) < hi)
#ifndef REP_MASK
#define REP_MASK 0
#endif
#define SEAM(k) do { if (IN(k) && IN((k) + 1)) xcd_barrier(bar); } while (0)

    if (IN(0)) { p0_prologue(args, lds, gw, NGW, lane, wave); }
    SEAM(0);
    if (IN(1)) {
        pg8::Gemm g{(const pg8::bf16_t*)(args.ws + WS_XN), (const pg8::bf16_t*)(args.ws + WS_WIN), MPAD / 256, NPROJ / 256, DM};
        pg8::StaticOrder S; S.init(g.nM, g.nN, G, bid, g.K / 64);
        EpiProj E{(bf16*)(args.ws + WS_QKV), (bf16*)(args.ws + WS_Z), (bf16*)(args.ws + WS_SQKV)};
        pg8::gemm_phase<EpiProj, pg8::AMapStd>(lds, g, S, E);
        if (!(args.sub & 128)) p1_ba(args, lds, bid, G, tid, lane, wave);
    }
    SEAM(1);
    if (IN(2)) {
        constexpr int N_PREP = NH * NCH, N_SAMP = DBATCH * NH, N_VT = 257;
        if (args.sub & 8) { PrepIn pin; prep_fetch(pin, args, bid, tid, lane);
            for (int e = tid; e < 64 * TS * 2 / 16; e += NTHR) *(LAS v4u*)(lds + L_TL + e * 16) = (v4u){0u, 0u, 0u, 0u};
            for (int it = bid; it < N_PREP; it += G) gdn_prep_item(args, lds, it, it + G < N_PREP ? it + G : -1, pin, tid, lane, wave); }
        constexpr int N_S2 = 248;
        if ((args.sub & 16) && bid >= N_PREP % 256 && bid - N_PREP % 256 < N_S2) gdn_sample_item(args, lds, bid - N_PREP % 256, tid, lane, wave);
        if (args.sub & 32) for (int it = G - 1 - bid; it < N_VT; it += G) vt_item(args, lds, it, tid);
        if (args.sub & 32) kv_outputs(args, (size_t)bid * NTHR + tid, (size_t)G * NTHR);
    }
    SEAM(2);
    constexpr int SCAN_BLOCKS = NH * 8 / SCAN_SL;
    if (IN(3)) {
        LAS int* bucket = (LAS int*)(lds + L_BUCKET);
        if (tid < 128) { const int n = tid; int bk = n;
            if (n >= 16) { const int lg = 16 + (int)(logf((float)n / 16.0f) / 2.0794415416798357f * 16.0f); bk = lg < 31 ? lg : 31; }
            bucket[tid] = bk; }
        __syncthreads();
        if (bid < SCAN_BLOCKS) { if (args.sub & 1) gdn_scan(args, lds, bid, wave, tid, lane); }
        else {
            const int nb = G - SCAN_BLOCKS, b2 = bid - SCAN_BLOCKS;
            constexpr int N_PS = 513, N_SS = DBATCH * KVH, N_SG = DBATCH * NH - 248;
            LAS float* btab = (LAS float*)(lds + L_BTAB) + wave * 160;
            for (int it = b2; it < N_PS + N_SS + N_SG; it += nb) {
                if (it < N_PS) { if (args.sub & 4) swa_prompt_block(args, lds, btab, bucket, it, tid, lane, wave); }
                else if (it < N_PS + N_SS) { if (args.sub & 2) swa_sample_item(args, lds, bucket, it - N_PS, tid, lane, wave); }
                else { if (args.sub & 16) gdn_sample_item(args, lds, 248 + it - N_PS - N_SS, tid, lane, wave); }
            }
            if (args.sub & 32) { swin_output(args, (size_t)b2 * NTHR + tid, (size_t)nb * NTHR); p5_ffn_weights(args, lds, b2 * NWAVES + wave, nb * NWAVES, lane, wave, 0); p5_ffn_weights(args, lds, b2 * NWAVES + wave, nb * NWAVES, lane, wave, 1); }
        }
    }
    SEAM(3);
    if (IN(4)) { gdn_out_phase(args, lds, bid, G, tid, lane, wave); }
    SEAM(4);
    if (IN(5)) {
        pg8::Gemm g{(const pg8::bf16_t*)(args.ws + WS_XN), (const pg8::bf16_t*)(args.ws + WS_WOUT), 64, DM / 256, DM};
        pg8::StaticOrder S; S.init(64, g.nN, G, bid, g.K / 64, 5, NSPLIT);
        EpiSplit E{(bf16*)(args.ws + WS_MIXOUT), DM, (float*)(args.ws + WS_PART), TAIL_ROW0, TAIL_ROWS};
        pg8::gemm_phase<EpiSplit, pg8::AMapStd>(lds, g, S, E);
    }
    SEAM(5);
    if (IN(6)) { p6_rows(args, gw, NGW, lane); }
    SEAM(6);
    if (IN(7)) {
        pg8::Gemm g{(const pg8::bf16_t*)(args.ws + WS_XN), (const pg8::bf16_t*)(args.ws + WS_WGU), FFN_NM, DFF / 128, DM};
        pg8::StaticOrder S; S.init(g.nM, g.nN, G, bid, g.K / 64);
        EpiFfn E{(bf16*)(args.ws + WS_ACT), args.in[22], args.in[6], args.out, (LAS float*)(lds + XCH_OFF)};
        pg8::gemm_phase<EpiFfn, AMapFfn>(lds, g, S, E);
    }
    SEAM(7);
    if (IN(8)) {
        pg8::Gemm g{(const pg8::bf16_t*)(args.ws + WS_ACT), (const pg8::bf16_t*)(args.ws + WS_WDOWN), 64, DM / 256, DFF};
        pg8::StaticOrder S; S.init(64, g.nN, G, bid, g.K / 64, 5, NSPLIT);
        EpiSplit E{(bf16*)(args.ws + WS_XN), DM, (float*)(args.ws + WS_PART), TAIL_ROW0, TAIL_ROWS};
        pg8::gemm_phase<EpiSplit, pg8::AMapStd>(lds, g, S, E);
    }
    SEAM(8);
    if (IN(9)) { p9_rows(args, lds, tid, gw, NGW, lane); }
#undef IN
#undef SEAM
}

extern "C" void kernel_launch(void* const* d_in, const int* in_sizes, int n_in, void* d_out, int out_size, void* d_ws, size_t ws_size, hipStream_t stream) {
    static int grid = 0;
    if (grid == 0) {
        if (n_in != 24 || (size_t)out_size != O_END || ws_size < WS_END) { fprintf(stderr, "kernel_launch: unexpected shapes (n_in %d, out %d, ws %zu)\n", n_in, out_size, ws_size); grid = -1; return; }
        int dev = 0, cus = 0;
        if (hipGetDevice(&dev) != hipSuccess || hipDeviceGetAttribute(&cus, hipDeviceAttributeMultiprocessorCount, dev) != hipSuccess) { grid = -1; return; }
        if (hipFuncSetAttribute((const void*)mega_fwd, hipFuncAttributeMaxDynamicSharedMemorySize, LDS_BYTES) != hipSuccess) { fprintf(stderr, "kernel_launch: hipFuncSetAttribute failed\n"); grid = -1; return; }
        (void)hipGetLastError();
        grid = cus;
    }
    if (grid < 0) return;
    if (hipMemsetAsync((char*)d_ws + WS_CTL, 0, CTL_ZERO_BYTES, stream) != hipSuccess) return;
    Args a{};
    for (int i = 0; i < 24; ++i) a.in[i] = (const float*)d_in[i];
    a.out = (float*)d_out; a.ws = (unsigned char*)d_ws; a.sub = 63;
#if MK_PER_PHASE
#ifndef REP_SUB
#define REP_SUB 63
#endif
#ifndef REP_N
#define REP_N 1
#endif
    for (int p = 0; p < N_PHASES; ++p) for (int rep = 0; rep < 1 + REP_N * ((REP_MASK >> p) & 1); ++rep) { a.ph_lo = p; a.ph_hi = p + 1; a.sub = rep ? REP_SUB : 63; hipLaunchKernelGGL(mega_fwd, dim3(grid), dim3(NTHR), LDS_BYTES, stream, a); }
#else
    a.ph_lo = 0; a.ph_hi = N_PHASES;
    hipLaunchKernelGGL(mega_fwd, dim3(grid), dim3(NTHR), LDS_BYTES, stream, a);
#endif
}
```

```cpp
#include <hip/hip_runtime.h>
#include <cstdio>
#include <cstdint>

namespace pg8 {
#define PG8_LAS __attribute__((address_space(3)))
typedef unsigned short bf16_t;
typedef short bf16x8 __attribute__((ext_vector_type(8)));
typedef float f32x4 __attribute__((ext_vector_type(4)));
typedef unsigned u32x4 __attribute__((ext_vector_type(4)));
constexpr int BM = 256, BK = 64, HALF = 128, HTB = HALF * BK * 2  , STAGE_BYTES = 8 * HTB, NXCD = 8, WGM = 4;

__host__ __device__ __forceinline__ int lds_byte(int r, int c) { const int st = (r >> 4) * 2 + (c >> 5), rr = r & 15, cc = c & 31, ob = rr * 64 + cc * 2; return st * 1024 + (ob ^ (((ob >> 9) & 1) << 5)); }
__host__ __device__ __forceinline__ void stage_rc(int b, int& R, int& C) { const int st = b / 1024, sb = b % 1024, swz = sb ^ (((sb >> 9) & 1) << 5); R = (st >> 1) * 16 + swz / 64; C = (st & 1) * 32 + (swz % 64) / 2; }
__host__ __device__ __forceinline__ int perm32(int rho) { const int n = rho >> 4, i = rho & 15; return 8 * (i >> 2) + 4 * n + (i & 3); }

struct Unit { int pm, pn, kt0, nk, sp; };
struct Gemm { const bf16_t* A; const bf16_t* Bt; int nM, nN, K; };

struct StaticOrder {
    int nM, nN, nwg, G, c, ktiles, nMt, nsp;
    __host__ __device__ void init(int nM_, int nN_, int G_, int c_, int ktiles_, int nMt_ = 0, int nsp_ = 1) { nM = nM_; nN = nN_; nwg = nM * nN; G = G_; c = c_; ktiles = ktiles_; nMt = nMt_; nsp = nsp_; }
    __host__ __device__ __forceinline__ bool next(int i, Unit& u) const {
        const long L = (long)i * G + c;
        const bool tail = L >= nwg;
        const int Lt = (int)(L - nwg), nt_ = nMt * nN;
        if (tail && Lt >= nt_ * nsp) return false;
        int wgid = tail ? 0 : (int)L; { const int q = nwg / NXCD, r = nwg % NXCD, xcd = wgid % NXCD, off = wgid / NXCD; wgid = (xcd < r ? xcd * (q + 1) : r * (q + 1) + (xcd - r) * q) + off; }
        const int nig = WGM * nN, gid = wgid / nig, fm = gid * WGM, gsz = (nM - fm) < WGM ? (nM - fm) : WGM;
        const int sp = tail ? Lt / (nt_ > 0 ? nt_ : 1) : -1, w = tail ? Lt % (nt_ > 0 ? nt_ : 1) : 0;
        const int prs = ktiles / 2, qs = prs / nsp, rs = prs % nsp, spc = sp < 0 ? 0 : sp;
        const int nks = 2 * (qs + (spc < rs ? 1 : 0)), kts = 2 * (spc * qs + (spc < rs ? spc : rs));
        Unit r_;
        r_.pm = tail ? nM + w / nN : fm + ((wgid % nig) % gsz);
        r_.pn = tail ? w % nN : (wgid % nig) / gsz;
        r_.kt0 = tail ? kts : 0; r_.nk = tail ? nks : ktiles; r_.sp = sp;
        u = r_; return true;
    }
};

struct AMapStd {
    static constexpr int HSTEP_ROWS = 128;
    static __host__ __device__ __forceinline__ int row_in_half(int R) { return R; }
    static __host__ __device__ __forceinline__ long base_row(int pm) { return (long)pm * 256; }
};

__device__ __forceinline__ unsigned cvt_pk_bf16(float lo, float hi) { unsigned r; asm volatile("v_cvt_pk_bf16_f32 %0, %1, %2" : "=v"(r) : "v"(lo), "v"(hi)); return r; }

template <class Epi, class AM, bool ALIGN_EPI = true>
__device__ __forceinline__ void gemm_phase(PG8_LAS unsigned char* lds, const Gemm g, const StaticOrder& S, const Epi& E) {
    const int tid = threadIdx.x, wid = __builtin_amdgcn_readfirstlane(tid >> 6), lane = tid & 63, wr = wid >> 2, wc = wid & 3, fr = lane & 15, fq = lane >> 4;
    const int K = g.K;
    unsigned voffA[2], voffB[2];
#pragma unroll
    for (int i = 0; i < 2; ++i) { int R, C; stage_rc(tid * 16 + i * 8192, R, C); const int Rb = Epi::PERM ? ((R & ~31) + perm32(R & 31)) : R;
        voffA[i] = (unsigned)(AM::row_in_half(R) * K + C) * 2u; voffB[i] = (unsigned)(Rb * K + C) * 2u; }
    const size_t kstep = (size_t)(BK * 2);
    const size_t hstepB = (size_t)HALF * K * 2;
    const size_t hstepA = (size_t)AM::HSTEP_ROWS * K * 2;
    const size_t tstepB = 2 * hstepB;
    const size_t rowb = (size_t)K * 2;
    const unsigned ldsw = (unsigned)wid * 1024u;
    const int aoff = lds_byte(wr * 64 + fr, fq * 8), boff = lds_byte(wc * 32 + fr, fq * 8);
#define PG8_SA(b, h) (((b) * 2 + (h)) * HTB)
#define PG8_SB(b, h) ((4 + (b) * 2 + (h)) * HTB)
#define PG8_STAGE(bufoff, gbase, voff) do { _Pragma("unroll") for (int _i = 0; _i < 2; ++_i) \
        __builtin_amdgcn_global_load_lds((const unsigned*)((const char*)(gbase) + (voff)[_i]), (PG8_LAS unsigned*)(lds + (bufoff) + ldsw + _i * 8192), 16, 0, 0); } while (0)
#define PG8_LDA(dst, b, h) do { _Pragma("unroll") for (int m = 0; m < 4; ++m) _Pragma("unroll") for (int k = 0; k < 2; ++k) dst[m][k] = *(const PG8_LAS bf16x8*)(lds + PG8_SA(b, h) + aoff + m * 2048 + k * 1024); } while (0)
#define PG8_LDB(dst, b, h) do { _Pragma("unroll") for (int n = 0; n < 2; ++n) _Pragma("unroll") for (int k = 0; k < 2; ++k) dst[n][k] = *(const PG8_LAS bf16x8*)(lds + PG8_SB(b, h) + boff + n * 2048 + k * 1024); } while (0)
#define PG8_MMA(ai, bj, At, Bt) do { __builtin_amdgcn_s_setprio(1); _Pragma("unroll") for (int m = 0; m < 4; ++m) _Pragma("unroll") for (int n = 0; n < 2; ++n) _Pragma("unroll") for (int k = 0; k < 2; ++k) \
        acc[ai][bj][m][n] = __builtin_amdgcn_mfma_f32_16x16x32_bf16(Bt[n][k], At[m][k], acc[ai][bj][m][n], 0, 0, 0); __builtin_amdgcn_s_setprio(0); } while (0)
#define PG8_WAIT_V(n) asm volatile("s_waitcnt vmcnt(" #n ")" ::: "memory")
#define PG8_WAIT_L(n) asm volatile("s_waitcnt lgkmcnt(" #n ")" ::: "memory")
#define PG8_BAR __builtin_amdgcn_s_barrier()
#define PG8_SCHED __builtin_amdgcn_sched_barrier(0)
    Unit cur, nxt; int ui = 0;
    if (!S.next(0, cur)) return;
    f32x4 acc[2][2][4][2];
#pragma unroll
    for (int a = 0; a < 2; ++a)
#pragma unroll
        for (int b = 0; b < 2; ++b)
#pragma unroll
            for (int m = 0; m < 4; ++m)
#pragma unroll
                for (int n = 0; n < 2; ++n) acc[a][b][m][n] = (f32x4){0.f, 0.f, 0.f, 0.f};
    bf16x8 At[4][2], B0[2][2], B1[2][2];
    const char* cA = (const char*)g.A + (size_t)AM::base_row(cur.pm) * rowb + (size_t)cur.kt0 * kstep; const char* cB = (const char*)g.Bt + (size_t)cur.pn * tstepB + (size_t)cur.kt0 * kstep;
    PG8_STAGE(PG8_SB(0, 0), cB, voffB); PG8_STAGE(PG8_SB(0, 1), cB + hstepB, voffB); PG8_STAGE(PG8_SA(0, 0), cA, voffA); PG8_STAGE(PG8_SA(0, 1), cA + hstepA, voffA);
    if (wr == 1) PG8_BAR;
    PG8_WAIT_V(2); PG8_BAR;
    PG8_STAGE(PG8_SB(1, 0), cB + kstep, voffB); PG8_STAGE(PG8_SA(1, 0), cA + kstep, voffA); PG8_STAGE(PG8_SB(1, 1), cB + hstepB + kstep, voffB);
    PG8_WAIT_V(6); PG8_BAR;
    for (;;) {
        const bool has_next = S.next(ui + 1, nxt);
        const char* nA = has_next ? (const char*)g.A + (size_t)AM::base_row(nxt.pm) * rowb + (size_t)nxt.kt0 * kstep : cA; const char* nB = has_next ? (const char*)g.Bt + (size_t)nxt.pn * tstepB + (size_t)nxt.kt0 * kstep : cB;
        const int nt = cur.nk;
        for (int t = 0; t < nt; t += 2) {
            const bool last = (t == nt - 2);
            const char* a1 = cA + (size_t)(t + 1) * kstep;
            const char* a2 = last ? nA : cA + (size_t)(t + 2) * kstep; const char* b2 = last ? nB : cB + (size_t)(t + 2) * kstep;
            const char* a3 = a2 + kstep; const char* b3 = b2 + kstep;
            PG8_LDB(B0, 0, 0); PG8_LDB(B1, 0, 1); PG8_SCHED; PG8_LDA(At, 0, 0); PG8_STAGE(PG8_SA(1, 1), a1 + hstepA, voffA);
            PG8_WAIT_V(8); PG8_WAIT_L(0); PG8_BAR; PG8_MMA(0, 0, At, B0); PG8_MMA(0, 1, At, B1); PG8_BAR; PG8_SCHED;
            PG8_LDA(At, 0, 1); PG8_STAGE(PG8_SB(0, 0), b2, voffB); PG8_STAGE(PG8_SB(0, 1), b2 + hstepB, voffB); PG8_STAGE(PG8_SA(0, 0), a2, voffA);
            PG8_WAIT_V(8); PG8_WAIT_L(0); PG8_BAR; PG8_MMA(1, 0, At, B0); PG8_MMA(1, 1, At, B1); PG8_BAR; PG8_SCHED;
            PG8_LDB(B0, 1, 0); PG8_LDB(B1, 1, 1); PG8_SCHED; PG8_LDA(At, 1, 0); PG8_STAGE(PG8_SA(0, 1), a2 + hstepA, voffA);
            PG8_WAIT_V(8); PG8_WAIT_L(0); PG8_BAR; PG8_MMA(0, 0, At, B0); PG8_MMA(0, 1, At, B1); PG8_BAR; PG8_SCHED;
            PG8_LDA(At, 1, 1); PG8_STAGE(PG8_SB(1, 0), b3, voffB); PG8_STAGE(PG8_SB(1, 1), b3 + hstepB, voffB); PG8_STAGE(PG8_SA(1, 0), a3, voffA);
            PG8_WAIT_V(8); PG8_WAIT_L(0); PG8_BAR; PG8_MMA(1, 0, At, B0); PG8_MMA(1, 1, At, B1); PG8_BAR; PG8_SCHED;
        }
        if constexpr (ALIGN_EPI) { if (wr == 0) PG8_BAR; }
        E(acc, cur, wr, wc, fr, fq);
        if (!has_next) break;
#pragma unroll
        for (int a = 0; a < 2; ++a)
#pragma unroll
            for (int b = 0; b < 2; ++b)
#pragma unroll
                for (int m = 0; m < 4; ++m)
#pragma unroll
                    for (int n = 0; n < 2; ++n) acc[a][b][m][n] = (f32x4){0.f, 0.f, 0.f, 0.f};
        cur = nxt; cA = nA; cB = nB; ++ui;
        if constexpr (ALIGN_EPI) { if (wr == 1) PG8_BAR; }
    }
    PG8_WAIT_V(0);
    if constexpr (!ALIGN_EPI) { if (wr == 0) PG8_BAR; }
    PG8_BAR;
#undef PG8_SA
#undef PG8_SB
#undef PG8_STAGE
#undef PG8_LDA
#undef PG8_LDB
#undef PG8_MMA
#undef PG8_WAIT_V
#undef PG8_WAIT_L
#undef PG8_BAR
#undef PG8_SCHED
}
}

constexpr int NWAVES = 8, NTHR = 512;
constexpr int DM = 2048, NMETA = 16, SEQ = 16384, NPOS = NMETA + SEQ  , DBATCH = 128, DSEQ = 8, NSAMP = DBATCH * DSEQ;
constexpr int ROW_S = 16448;
constexpr int MPAD = 17664;
constexpr int HD = 128, NH = 8, KVH = 2, GW = 1024, QKVD = 3072, DFF = 5632, NCH = 257, CH = 64;
constexpr int PAST = 16384, WIN = 128;
constexpr float EPS = 1e-6f;
constexpr int NPROJ = 5632, SQKV_LD = 1536;

constexpr size_t O_YP = 0, O_YS = O_YP + (size_t)SEQ * DM, O_PMETA = O_YS + (size_t)NSAMP * DM, O_PWIN = O_PMETA + 16 * 2 * 2 * 128, O_PGC = O_PWIN + 128 * 2 * 2 * 128,
                 O_PGS = O_PGC + 3 * QKVD, O_PFC = O_PGS + (size_t)NH * HD * HD, O_SWIN = O_PFC + 2 * DFF, O_SGC = O_SWIN + (size_t)DBATCH * 128 * 512, O_SGS = O_SGC + (size_t)DBATCH * 3 * QKVD,
                 O_SFC = O_SGS + (size_t)DBATCH * NH * HD * HD, O_END = O_SFC + (size_t)DBATCH * 2 * DFF;

constexpr size_t MiB = 1u << 20;
constexpr size_t WS_CTL = 0, CTL_ZERO_BYTES = 64 * 1024, WS_SSTATE = 256 * 1024;
constexpr size_t WS_BA = 1 * MiB;
constexpr size_t WS_GL = 3 * MiB;
constexpr size_t WS_WIN = 4 * MiB;
constexpr size_t WS_WBA = 27 * MiB;
constexpr size_t WS_WOUT = 28 * MiB;
constexpr size_t WS_XN = 36 * MiB;
constexpr size_t WS_VT = 106 * MiB;
constexpr int VT_LD = 16512;
constexpr size_t WS_QKV = 116 * MiB;
constexpr size_t WS_Z = 220 * MiB;
constexpr size_t WS_SQKV = 255 * MiB;
constexpr size_t WS_SCANIN = 307 * MiB;
constexpr size_t SCANIN_ITEM = 73728, SI_W = 0, SI_KD = 16384, SI_U = 32768, SI_QG = 49152, SI_QK = 65536;
constexpr size_t WS_SCANOUT = WS_QKV;
constexpr size_t SCANOUT_ITEM = 49152;
constexpr size_t WS_WGU = 452 * MiB;
constexpr size_t WS_WDOWN = 4 * MiB;
constexpr size_t WS_MIXOUT = 116 * MiB;
constexpr size_t WS_ACT = 255 * MiB;
constexpr size_t WS_PART = 186 * MiB;
constexpr int TAIL_ROW0 = 16384, TAIL_ROWS = 1280, NSPLIT = 4;
constexpr size_t WS_END = 496 * MiB;
static_assert(WS_WIN + (size_t)NPROJ * DM * 2 <= WS_WBA && WS_WOUT + (size_t)DM * DM * 2 <= WS_XN && WS_XN + (size_t)MPAD * DM * 2 <= WS_VT, "ws map 1");
static_assert(WS_VT + (size_t)2 * 128 * VT_LD * 2 <= WS_QKV && WS_QKV + (size_t)MPAD * QKVD * 2 <= WS_Z && WS_Z + (size_t)MPAD * 1024 * 2 <= WS_SQKV, "ws map 2");
static_assert(WS_SQKV + (size_t)MPAD * SQKV_LD * 2 <= WS_SCANIN && WS_SCANIN + (size_t)NH * NCH * SCANIN_ITEM <= WS_WGU, "ws map 3");
static_assert(WS_SCANOUT + (size_t)NH * NCH * SCANOUT_ITEM <= WS_Z, "ws map 4");
static_assert(WS_WGU + (size_t)2 * DFF * DM * 2 <= WS_END && WS_WDOWN + (size_t)DM * DFF * 2 <= WS_WBA && WS_MIXOUT + (size_t)MPAD * DM * 2 <= WS_Z && WS_ACT + (size_t)MPAD * DFF * 2 <= WS_WGU && WS_END <= 512 * MiB, "ws map 5");
constexpr int CW_BAR = 1024;

constexpr int RING_BYTES = 131072;
constexpr int MISC_OFF = 147456 - 256;
constexpr int XCH_OFF = RING_BYTES;
constexpr int LDS_BYTES = 147456;

#define GAS __attribute__((address_space(1)))
#define LAS __attribute__((address_space(3)))
typedef unsigned short bf16;
typedef unsigned v4u __attribute__((ext_vector_type(4)));
typedef unsigned v2u __attribute__((ext_vector_type(2)));
typedef float f32x4 __attribute__((ext_vector_type(4)));
typedef float f32x16 __attribute__((ext_vector_type(16)));
typedef short bf16x8 __attribute__((ext_vector_type(8)));
typedef GAS unsigned gu32;
#define RLX_AGENT __ATOMIC_RELAXED, __HIP_MEMORY_SCOPE_AGENT
#define DI __device__ __forceinline__
typedef float f32x2_ __attribute__((ext_vector_type(2)));
typedef __bf16 bf16x2_ __attribute__((ext_vector_type(2)));
DI unsigned pk2(float lo, float hi) { const f32x2_ v = {lo, hi}; return __builtin_bit_cast(unsigned, __builtin_convertvector(v, bf16x2_)); }
DI unsigned f2bf(float f) { return pk2(f, 0.f) & 0xffffu; }
DI float bf2f(unsigned short b) { return __builtin_bit_cast(float, (unsigned)b << 16); }
DI float bflo(unsigned w) { return __builtin_bit_cast(float, w << 16); }
DI float bfhi(unsigned w) { return __builtin_bit_cast(float, w & 0xffff0000u); }
#define LDS_SYNC() do { asm volatile("s_waitcnt lgkmcnt(0)" ::: "memory"); __builtin_amdgcn_s_barrier(); asm volatile("" ::: "memory"); } while (0)
DI float wave_sum(float v) {
#pragma unroll
    for (int o = 1; o < 64; o <<= 1) v += __shfl_xor(v, o);
    return v;
}
DI float sigmoidf_(float x) { return __builtin_amdgcn_rcpf(1.f + __expf(-x)); }
DI float siluf_(float x) { return x * __builtin_amdgcn_rcpf(1.f + __expf(-x)); }
DI float softplusf_(float x) { return x > 20.f ? x : log1pf(__expf(x)); }
DI f32x4 mfma16(bf16x8 a, bf16x8 b, f32x4 c) { return __builtin_amdgcn_mfma_f32_16x16x32_bf16(a, b, c, 0, 0, 0); }
DI f32x16 mfma32(bf16x8 a, bf16x8 b, f32x16 c) { return __builtin_amdgcn_mfma_f32_32x32x16_bf16(a, b, c, 0, 0, 0); }
DI bf16x8 pack8(float a0, float a1, float a2, float a3, float a4, float a5, float a6, float a7) {
    v4u p; p.x = pk2(a0, a1); p.y = pk2(a2, a3); p.z = pk2(a4, a5); p.w = pk2(a6, a7); return __builtin_bit_cast(bf16x8, p);
}

#define XB_TMO      128
#define XB_XCNT(j)  (256  + 64 * (j))
#define XB_XSUB(j)  (1280 + 64 * (j))
#define XB_XGEN(j)  (2304 + 64 * (j))
#define XB_TOP      3328
#define XB_TOPGEN   3392
#define XCD_BAR_WORDS 3456
#define XB_SPIN_CAP (1u << 18)
DI unsigned xb_ld(unsigned* p)              { return __hip_atomic_load(p, __ATOMIC_RELAXED, __HIP_MEMORY_SCOPE_AGENT); }
DI unsigned xb_add(unsigned* p, unsigned v) { return __hip_atomic_fetch_add(p, v, __ATOMIC_RELAXED, __HIP_MEMORY_SCOPE_AGENT); }
DI unsigned xb_xcc_id() { return (unsigned)__builtin_amdgcn_s_getreg((3 << 11) | 20) & 0xFu; }
#define XB_SPIN(cond, bar) do { unsigned _sp = 0; while (cond) { __builtin_amdgcn_s_sleep(1); \
    if ((++_sp & 255u) == 0u) { if (xb_ld(&(bar)[XB_TMO])) break; if (_sp > XB_SPIN_CAP) { atomicAdd(&(bar)[XB_TMO], 1u); break; } } } } while (0)
struct XcdBarrier { unsigned* bar; unsigned x; volatile LAS unsigned* st; };
DI XcdBarrier xcd_barrier_post(unsigned* bar, volatile LAS unsigned* st) {
    XcdBarrier b; b.bar = bar; b.x = xb_xcc_id(); b.st = st;
    if (threadIdx.x == 0) (void)xb_add(&bar[XB_XCNT(b.x)], 1u);
    return b;
}
DI void xcd_barrier_complete(unsigned* bar, unsigned x, unsigned& nloc, unsigned& nx) {
    const unsigned G = gridDim.x * gridDim.y * gridDim.z;
    unsigned sum, cnt, mine, sp = 0u;
    for (;;) {
        sum = 0u; cnt = 0u; mine = 0u;
#pragma unroll
        for (unsigned j = 0; j < 16; ++j) { const unsigned c = xb_ld(&bar[XB_XCNT(j)]); sum += c; cnt += (c > 0u) ? 1u : 0u; mine = (j == x) ? c : mine; }
        if (sum == G) break;
        __builtin_amdgcn_s_sleep(1);
        if ((++sp & 255u) == 0u) { if (xb_ld(&bar[XB_TMO])) break; if (sp > XB_SPIN_CAP) { atomicAdd(&bar[XB_TMO], 1u); break; } }
    }
    nloc = mine > 0u ? mine : 1u; nx = cnt > 0u ? cnt : 1u;
}
DI void xcd_barrier(const XcdBarrier& b) {
    asm volatile("s_waitcnt vmcnt(0)" ::: "memory");
    __syncthreads();
    if (threadIdx.x == 0) {
        unsigned* bar = b.bar;
        __builtin_amdgcn_s_waitcnt(0);
        unsigned nloc = b.st[0], nx = b.st[1];
        if (nloc == 0u) { xcd_barrier_complete(bar, b.x, nloc, nx); b.st[0] = nloc; b.st[1] = nx; }
        const unsigned old = xb_add(&bar[XB_XSUB(b.x)], 1u);
        const unsigned gen = old / nloc;
        if (old + 1u == (gen + 1u) * nloc) {
            __builtin_amdgcn_fence(__ATOMIC_RELEASE, "agent");
            asm volatile("s_waitcnt vmcnt(0)" ::: "memory");
            const unsigned og = xb_add(&bar[XB_TOP], 1u);
            const unsigned tg = og / nx;
            if (og + 1u == (tg + 1u) * nx) xb_add(&bar[XB_TOPGEN], 1u);
            else XB_SPIN(xb_ld(&bar[XB_TOPGEN]) == tg, bar);
            __builtin_amdgcn_fence(__ATOMIC_ACQUIRE, "agent");
            xb_add(&bar[XB_XGEN(b.x)], 1u);
            asm volatile("s_waitcnt vmcnt(0)" ::: "memory");
        } else {
            XB_SPIN(xb_ld(&bar[XB_XGEN(b.x)]) == gen, bar);
            __builtin_amdgcn_fence(__ATOMIC_ACQUIRE, "agent");
            asm volatile("s_waitcnt vmcnt(0)" ::: "memory");
        }
    }
    __syncthreads();
}

struct Args { const float* in[24]; float* out; unsigned char* ws; int ph_lo, ph_hi, sub, pad; };
struct Frame {
    LAS unsigned char* lds;
    int tid, lane, wave, G, bid;
    const float* const* in;
};

DI void transpose_item(const float* W, int src_ld, int src_col0, int k0, bf16* WT, int dst_ld, int dst_row0, LAS float* scr, int lane) {
#pragma unroll 8
    for (int i = 0; i < 32; ++i) { const int kk = 2 * i + (lane >> 5); scr[kk * 33 + (lane & 31)] = W[(size_t)(k0 + kk) * src_ld + src_col0 + (lane & 31)]; }
    asm volatile("s_waitcnt lgkmcnt(0)" ::: "memory");
    const int c = lane & 7;
#pragma unroll
    for (int j = 0; j < 4; ++j) { const int n = (lane >> 3) + 8 * j; const LAS float* s = scr + (8 * c) * 33 + n;
        v4u o; o.x = pk2(s[0 * 33], s[1 * 33]); o.y = pk2(s[2 * 33], s[3 * 33]); o.z = pk2(s[4 * 33], s[5 * 33]); o.w = pk2(s[6 * 33], s[7 * 33]);
        *(GAS v4u*)(WT + (size_t)(dst_row0 + n) * dst_ld + k0 + 8 * c) = o; }
    asm volatile("s_waitcnt lgkmcnt(0)" ::: "memory");
}
DI void rms_row_to_bf16(const float* xrow, const f32x4 (&wv)[8], bf16* orow, int lane) {
    GAS unsigned long long* o8 = (GAS unsigned long long*)orow + lane;
    if (!xrow) {
#pragma unroll
        for (int j = 0; j < 8; ++j) o8[64 * j] = 0ull;
        return; }
    const GAS f32x4* xr = (const GAS f32x4*)xrow + lane;
    f32x4 v[8]; float s = 0.f;
#pragma unroll
    for (int j = 0; j < 8; ++j) { v[j] = xr[64 * j]; s += (v[j].x * v[j].x + v[j].y * v[j].y) + (v[j].z * v[j].z + v[j].w * v[j].w); }
    const float rstd = 1.f / sqrtf(wave_sum(s) * (1.f / DM) + EPS);
#pragma unroll
    for (int j = 0; j < 8; ++j) { const f32x4 ww = wv[j];
        o8[64 * j] = (unsigned long long)pk2(v[j].x * rstd * ww.x, v[j].y * rstd * ww.y) | ((unsigned long long)pk2(v[j].z * rstd * ww.z, v[j].w * rstd * ww.w) << 32); }
}
DI const float* x_row(const Args& a, int r) {
    if (r < NMETA) return a.in[7] + (size_t)r * DM;
    if (r < NPOS) return a.in[0] + (size_t)(r - NMETA) * DM;
    if (r < ROW_S) return nullptr;
    if (r < ROW_S + NSAMP) return a.in[1] + (size_t)(r - ROW_S) * DM;
    return nullptr;
}
DI void p0_prologue(const Args& a, LAS unsigned char* lds, int gw, int NGW, int lane, int wave) {
    LAS float* scr = (LAS float*)(lds + wave * 16384);
    bf16* WIN = (bf16*)(a.ws + WS_WIN); bf16* WBA = (bf16*)(a.ws + WS_WBA); bf16* XN = (bf16*)(a.ws + WS_XN);
    constexpr int I_IN = 32 * (NPROJ / 32);
    for (int it = gw; it < I_IN; it += NGW) { const int kb = it / (NPROJ / 32), nb = it % (NPROJ / 32); const int n0 = 32 * nb;
        transpose_item(a.in[9], 5648, n0 + (n0 >= 4096 ? 16 : 0), 64 * kb, WIN, DM, n0, scr, lane); }
    for (int e = gw * 64 + lane; e < 16 * DM; e += NGW * 64) { const int n = e / DM, k = e % DM; WBA[e] = (bf16)f2bf(a.in[9][(size_t)k * 5648 + 4096 + n]); }
    f32x4 wv[8];
#pragma unroll
    for (int j = 0; j < 8; ++j) wv[j] = ((const GAS f32x4*)a.in[16])[lane + 64 * j];
    for (int m = gw; m < MPAD; m += NGW) rms_row_to_bf16(x_row(a, m), wv, XN + (size_t)m * DM, lane);
}
DI void p3_wout(const Args& a, LAS unsigned char* lds, int gw, int NGW, int lane, int wave) {
    LAS float* scr = (LAS float*)(lds + wave * 16384);
    bf16* WOUT = (bf16*)(a.ws + WS_WOUT);
    constexpr int I_OUT = 32 * (DM / 32);
    for (int it = gw; it < I_OUT; it += NGW) { const int kb = it / (DM / 32), nb = it % (DM / 32); transpose_item(a.in[15], DM, 32 * nb, 64 * kb, WOUT, DM, 32 * nb, scr, lane); }
}
DI void p5_ffn_weights(const Args& a, LAS unsigned char* lds, int gw, int NGW, int lane, int wave, int part) {
    LAS float* scr = (LAS float*)(lds + wave * 16384);
    bf16* WGU = (bf16*)(a.ws + WS_WGU); bf16* WDOWN = (bf16*)(a.ws + WS_WDOWN);
    constexpr int I_GU = 32 * (2 * DFF / 32), I_DN = (DFF / 64) * (DM / 32);
    for (int it = (part ? I_GU : 0) + gw; it < (part ? I_GU + I_DN : I_GU); it += NGW) {
        if (it < I_GU) { const int kb = it / (2 * DFF / 32), nb = it % (2 * DFF / 32); const int u = nb >> 3, bi = nb & 7;
            const float* src = bi < 4 ? a.in[20] : a.in[21];
            transpose_item(src, DFF, 128 * u + 32 * (bi & 3), 64 * kb, WGU, DM, 32 * nb, scr, lane); }
        else { const int r = it - I_GU; const int kb = r / (DM / 32), nb = r % (DM / 32); transpose_item(a.in[23], DM, 32 * nb, 64 * kb, WDOWN, DFF, 32 * nb, scr, lane); }
    }
}
constexpr int BA_RS = 4112, BA_AS = 528, BA_AOFF = 16 * BA_RS, BA_ABUF = 64 * BA_AS, BA_RED = BA_AOFF + 2 * BA_ABUF;
DI void p1_ba(const Args& a, LAS unsigned char* lds, int bid, int G, int tid, int lane, int wave) {
    const bf16* XN = (const bf16*)(a.ws + WS_XN); const bf16* WBA = (const bf16*)(a.ws + WS_WBA); float* BA = (float*)(a.ws + WS_BA);
    for (int e = tid; e < 16 * 256; e += NTHR) *(LAS v4u*)(lds + (e >> 8) * BA_RS + (e & 255) * 16) = *(const GAS v4u*)(WBA + (size_t)(e >> 8) * DM + (e & 255) * 8);
    const int r = lane & 15, q = lane >> 4, rs = wave & 3, kh = wave >> 2;
    constexpr int N_IT = MPAD / 64, N_UNITS = (MPAD / 256) * (NPROJ / 256);
    const int nfull = N_UNITS % G, nidle = G - nfull;
    for (int k = 0; k < 8; ++k) {
        const int it = k == 0 ? bid : (bid >= nfull && nfull > 0 ? G + (bid - nfull) + nidle * (k - 1) : (nfull > 0 ? N_IT : bid + k * G));
        if (it >= N_IT) break;
        const bf16* A0 = XN + (size_t)64 * it * DM;
        v4u st[4][4];
#pragma unroll
        for (int c = 0; c < 4; ++c)
#pragma unroll
            for (int j = 0; j < 4; ++j) { const int e = tid + 512 * j; st[c][j] = *(const GAS v4u*)(A0 + (size_t)(e >> 5) * DM + 256 * c + (e & 31) * 8); }
        f32x4 acc = {0.f, 0.f, 0.f, 0.f};
#pragma unroll
        for (int c = 0; c < 8; ++c) {
#pragma unroll
            for (int j = 0; j < 4; ++j) { const int e = tid + 512 * j; *(LAS v4u*)(lds + BA_AOFF + (c & 1) * BA_ABUF + (e >> 5) * BA_AS + (e & 31) * 16) = st[c & 3][j]; }
            if (c + 4 < 8) {
#pragma unroll
                for (int j = 0; j < 4; ++j) { const int e = tid + 512 * j; st[c & 3][j] = *(const GAS v4u*)(A0 + (size_t)(e >> 5) * DM + 256 * (c + 4) + (e & 31) * 8); }
            }
            LDS_SYNC();
            const LAS unsigned char* ab = lds + BA_AOFF + (c & 1) * BA_ABUF + (16 * rs + r) * BA_AS + 16 * q + 256 * kh;
            const LAS unsigned char* bb = lds + r * BA_RS + 512 * c + 16 * q + 256 * kh;
#pragma unroll
            for (int s = 0; s < 4; ++s) acc = mfma16(*(const LAS bf16x8*)(ab + 64 * s), *(const LAS bf16x8*)(bb + 64 * s), acc);
        }
        LDS_SYNC();
        LAS f32x4* red = (LAS f32x4*)(lds + BA_RED);
        if (kh == 1) red[rs * 64 + lane] = acc;
        LDS_SYNC();
        if (kh == 0) { acc += red[rs * 64 + lane];
#pragma unroll
            for (int i = 0; i < 4; ++i) BA[(size_t)(64 * it + 16 * rs + 4 * q + i) * 16 + r] = acc[i]; }
        LDS_SYNC();
    }
}

struct EpiProj {
    static constexpr bool PERM = true;
    bf16* qkv; bf16* z; bf16* sqkv;
    DI void operator()(const f32x4 (&acc)[2][2][4][2], const pg8::Unit& u, int wr, int wc, int fr, int fq) const {
        bf16* base; int ldc, colt;
        if (u.pn < 12) { base = qkv; ldc = QKVD; colt = u.pn * 256; } else if (u.pn < 16) { base = z; ldc = 1024; colt = (u.pn - 12) * 256; } else { base = sqkv; ldc = SQKV_LD; colt = (u.pn - 16) * 256; }
        const int row0 = u.pm * 256 + wr * 64 + fr, col0 = colt + wc * 32 + 8 * fq;
#pragma unroll
        for (int ai = 0; ai < 2; ++ai)
#pragma unroll
            for (int m = 0; m < 4; ++m) { bf16* rowp = base + (size_t)(row0 + ai * 128 + m * 16) * ldc + col0;
#pragma unroll
                for (int bj = 0; bj < 2; ++bj) { const f32x4 v0 = acc[ai][bj][m][0], v1 = acc[ai][bj][m][1];
                    v4u w; w.x = pg8::cvt_pk_bf16(v0[0], v0[1]); w.y = pg8::cvt_pk_bf16(v0[2], v0[3]); w.z = pg8::cvt_pk_bf16(v1[0], v1[1]); w.w = pg8::cvt_pk_bf16(v1[2], v1[3]);
                    *(v4u*)(rowp + bj * 128) = w; } }
    }
};
struct EpiSplit {
    static constexpr bool PERM = true;
    bf16* O; int ldc; float* P; int row0, prow;
    DI void operator()(const f32x4 (&acc)[2][2][4][2], const pg8::Unit& u, int wr, int wc, int fr, int fq) const {
        const int rowb = u.pm * 256 + wr * 64 + fr, col0 = u.pn * 256 + wc * 32 + 8 * fq;
#pragma unroll
        for (int ai = 0; ai < 2; ++ai)
#pragma unroll
            for (int m = 0; m < 4; ++m) { const int row = rowb + ai * 128 + m * 16;
#pragma unroll
                for (int bj = 0; bj < 2; ++bj) { const f32x4 v0 = acc[ai][bj][m][0], v1 = acc[ai][bj][m][1];
                    if (u.sp < 0) { v4u w; w.x = pg8::cvt_pk_bf16(v0[0], v0[1]); w.y = pg8::cvt_pk_bf16(v0[2], v0[3]); w.z = pg8::cvt_pk_bf16(v1[0], v1[1]); w.w = pg8::cvt_pk_bf16(v1[2], v1[3]);
                        *(v4u*)(O + (size_t)row * ldc + col0 + bj * 128) = w; }
                    else { float* pp = P + ((size_t)u.sp * prow + (row - row0)) * ldc + col0 + bj * 128; *(f32x4*)pp = v0; *(f32x4*)(pp + 4) = v1; } } }
    }
};
struct EpiPlain {
    static constexpr bool PERM = true;
    bf16* O; int ldc;
    DI void operator()(const f32x4 (&acc)[2][2][4][2], const pg8::Unit& u, int wr, int wc, int fr, int fq) const {
        const int row0 = u.pm * 256 + wr * 64 + fr, col0 = u.pn * 256 + wc * 32 + 8 * fq;
#pragma unroll
        for (int ai = 0; ai < 2; ++ai)
#pragma unroll
            for (int m = 0; m < 4; ++m) { bf16* rowp = O + (size_t)(row0 + ai * 128 + m * 16) * ldc + col0;
#pragma unroll
                for (int bj = 0; bj < 2; ++bj) { const f32x4 v0 = acc[ai][bj][m][0], v1 = acc[ai][bj][m][1];
                    v4u w; w.x = pg8::cvt_pk_bf16(v0[0], v0[1]); w.y = pg8::cvt_pk_bf16(v0[2], v0[3]); w.z = pg8::cvt_pk_bf16(v1[0], v1[1]); w.w = pg8::cvt_pk_bf16(v1[2], v1[3]);
                    *(v4u*)(rowp + bj * 128) = w; } }
    }
};

constexpr int FFN_PT = 65, FFN_NM = 69;
struct AMapFfn {
    static constexpr int HSTEP_ROWS = 4;
    static __host__ __device__ __forceinline__ int row_in_half(int R) { return 128 * ((R >> 6) & 1) + 8 * (R & 15) + ((R >> 4) & 3); }
    static __host__ __device__ __forceinline__ long base_row(int pm) { return pm < FFN_PT ? (long)(NMETA + 254 * pm - 2) : (long)(ROW_S + 256 * (pm - FFN_PT)); }
};
struct EpiFfn {
    static constexpr bool PERM = true;
    bf16* act; const float* cw; const float* hist; float* out; LAS float* xch;
    DI void operator()(const f32x4 (&acc)[2][2][4][2], const pg8::Unit& u, int wr, int wc, int fr, int fq) const {
        const bool samp = u.pm >= FFN_PT;
        const int rho = 16 * wr + fr, colb = 128 * u.pn + 32 * wc + 8 * fq;
        const long row0 = AMapFfn::base_row(u.pm) + 8 * rho;
        if (wr == 0 && fr == 15) {
#pragma unroll
            for (int n = 0; n < 2; ++n)
#pragma unroll
                for (int e = 0; e < 4; ++e) { xch[(wc * 2 + 0) * 32 + 8 * fq + 4 * n + e] = acc[1][0][2][n][e]; xch[(wc * 2 + 1) * 32 + 8 * fq + 4 * n + e] = acc[1][0][3][n][e]; }
        }
        asm volatile("s_waitcnt lgkmcnt(0)" ::: "memory"); __builtin_amdgcn_s_barrier(); asm volatile("" ::: "memory");
        unsigned res[8][4]; float aprev[8];
        const bool tailt = !samp && u.pm == FFN_PT - 1;
        const int sb_ = 32 * (u.pm - FFN_PT) + rho;
#pragma unroll
        for (int n = 0; n < 2; ++n) {
            const int col4 = colb + 4 * n;
            const f32x4 w0v = *(const f32x4*)(cw + col4), w1v = *(const f32x4*)(cw + DFF + col4), w2v = *(const f32x4*)(cw + 2 * DFF + col4);
            f32x4 h0v = {0.f, 0.f, 0.f, 0.f}, h1v = {0.f, 0.f, 0.f, 0.f};
            if (samp) { h0v = *(const f32x4*)(hist + (size_t)(sb_ * 2 + 0) * DFF + col4); h1v = *(const f32x4*)(hist + (size_t)(sb_ * 2 + 1) * DFF + col4); }
            f32x4 g6v, g7v;
#pragma unroll
            for (int e = 0; e < 4; ++e) {
                const int col = col4 + e;
                const float w0 = w0v[e], w1 = w1v[e], w2 = w2v[e];
                float g[8], up[8];
#pragma unroll
                for (int j = 0; j < 8; ++j) { g[j] = acc[j >> 2][0][j & 3][n][e]; up[j] = acc[j >> 2][1][j & 3][n][e]; }
                float pm1 = __shfl_up(g[7], 1), pm2 = __shfl_up(g[6], 1);
                if (samp) { pm2 = h0v[e]; pm1 = h1v[e]; }
                else if (fr == 0) { if (wr == 1) { pm2 = xch[(wc * 2 + 0) * 32 + 8 * fq + 4 * n + e]; pm1 = xch[(wc * 2 + 1) * 32 + 8 * fq + 4 * n + e]; } else { pm1 = 0.f; pm2 = 0.f; } }
#pragma unroll
                for (int j = 0; j < 8; ++j) {
                    const float gm1 = j >= 1 ? g[j - 1] : pm1, gm2 = j >= 2 ? g[j - 2] : (j == 1 ? pm1 : pm2);
                    const float c = w0 * gm2 + w1 * gm1 + w2 * g[j];
                    const float a = siluf_(c) * up[j];
                    if ((e & 1) == 0) aprev[j] = a; else res[j][2 * n + (e >> 1)] = pk2(aprev[j], a);
                }
                g6v[e] = g[6]; g7v[e] = g[7];
                if (tailt) {
#pragma unroll
                    for (int j = 0; j < 8; ++j) { const long r = row0 + j; if (r == NPOS - 2) out[O_PFC + col] = g[j]; if (r == NPOS - 1) out[O_PFC + DFF + col] = g[j]; }
                }
            }
            if (samp) { *(f32x4*)(out + O_SFC + (size_t)(sb_ * 2 + 0) * DFF + col4) = g6v; *(f32x4*)(out + O_SFC + (size_t)(sb_ * 2 + 1) * DFF + col4) = g7v; }
        }
#pragma unroll
        for (int j = 0; j < 8; ++j) {
            const long r = row0 + j; const bool ok = samp ? true : ((8 * rho + j >= 2) && r < NPOS);
            if (ok) { v4u w; w.x = res[j][0]; w.y = res[j][1]; w.z = res[j][2]; w.w = res[j][3]; *(v4u*)(act + (size_t)r * DFF + colb) = w; }
        }
    }
};

DI float sumsq8(const f32x4 (&v)[8]) { float s = 0.f;
#pragma unroll
    for (int j = 0; j < 8; ++j) s += (v[j].x * v[j].x + v[j].y * v[j].y) + (v[j].z * v[j].z + v[j].w * v[j].w);
    return s; }
DI f32x4 bf4(v2u w) { return (f32x4){bflo(w.x), bfhi(w.x), bflo(w.y), bfhi(w.y)}; }
struct Row6 { f32x4 x[8]; v2u m[8]; };
DI void row6_load(Row6& r, const Args& a, int m, int lane) {
    const GAS f32x4* xr = (const GAS f32x4*)x_row(a, m) + lane; const GAS v2u* mr = (const GAS v2u*)((const bf16*)(a.ws + WS_MIXOUT) + (size_t)m * DM) + lane;
#pragma unroll
    for (int j = 0; j < 8; ++j) { r.x[j] = xr[64 * j]; r.m[j] = mr[64 * j]; }
}
DI void row6_finish(const f32x4 (&mv)[8], const f32x4 (&xv)[8], const f32x4 (&wp)[8], const f32x4 (&wf)[8], bf16* xn2row, bf16* h1row, int lane) {
    const float rstd = __builtin_amdgcn_rsqf(wave_sum(sumsq8(mv)) * (1.f / DM) + EPS);
    f32x4 hv[8];
#pragma unroll
    for (int j = 0; j < 8; ++j) hv[j] = xv[j] + mv[j] * rstd * wp[j];
    const float rstd2 = __builtin_amdgcn_rsqf(wave_sum(sumsq8(hv)) * (1.f / DM) + EPS);
    GAS v2u* h8 = (GAS v2u*)h1row + lane;
#pragma unroll
    for (int j = 0; j < 8; ++j) h8[64 * j] = (v2u){pk2(hv[j].x, hv[j].y), pk2(hv[j].z, hv[j].w)};
    GAS unsigned long long* o8 = (GAS unsigned long long*)xn2row + lane;
#pragma unroll
    for (int j = 0; j < 8; ++j) { const f32x4 ww = wf[j];
        o8[64 * j] = (unsigned long long)pk2(hv[j].x * rstd2 * ww.x, hv[j].y * rstd2 * ww.y) | ((unsigned long long)pk2(hv[j].z * rstd2 * ww.z, hv[j].w * rstd2 * ww.w) << 32); }
}
DI void p6_rows(const Args& a, int gw, int NGW, int lane) {
    bf16* XN2 = (bf16*)(a.ws + WS_XN); bf16* MO = (bf16*)(a.ws + WS_MIXOUT);
    f32x4 wp[8], wf[8];
#pragma unroll
    for (int j = 0; j < 8; ++j) { wp[j] = ((const GAS f32x4*)a.in[17])[lane + 64 * j]; wf[j] = ((const GAS f32x4*)a.in[18])[lane + 64 * j]; }
    {
        Row6 A, B; int m = gw;
        if (m < TAIL_ROW0) row6_load(A, a, m, lane);
        for (; m < TAIL_ROW0; m += 2 * NGW) {
            const int m1 = m + NGW, m2 = m + 2 * NGW;
            if (m1 < TAIL_ROW0) row6_load(B, a, m1, lane);
            { f32x4 mv[8];
#pragma unroll
              for (int j = 0; j < 8; ++j) mv[j] = bf4(A.m[j]);
              row6_finish(mv, A.x, wp, wf, XN2 + (size_t)m * DM, MO + (size_t)m * DM, lane); }
            if (m1 >= TAIL_ROW0) break;
            if (m2 < TAIL_ROW0) row6_load(A, a, m2, lane);
            { f32x4 mv[8];
#pragma unroll
              for (int j = 0; j < 8; ++j) mv[j] = bf4(B.m[j]);
              row6_finish(mv, B.x, wp, wf, XN2 + (size_t)m1 * DM, MO + (size_t)m1 * DM, lane); }
        }
    }
    for (int m = TAIL_ROW0 + gw; m < MPAD; m += NGW) {
        const float* xrow = x_row(a, m);
        if (!xrow) { GAS unsigned long long* o8 = (GAS unsigned long long*)(XN2 + (size_t)m * DM) + lane;
#pragma unroll
            for (int j = 0; j < 8; ++j) o8[64 * j] = 0ull;
            continue; }
        const GAS f32x4* xr = (const GAS f32x4*)xrow + lane;
        const GAS f32x4* pr = (const GAS f32x4*)((const float*)(a.ws + WS_PART) + (size_t)(m - TAIL_ROW0) * DM) + lane;
        f32x4 mv[8], xv[8];
#pragma unroll
        for (int j = 0; j < 8; ++j) { xv[j] = xr[64 * j]; mv[j] = pr[64 * j]; }
#pragma unroll 1
        for (int sp = 1; sp < NSPLIT; ++sp) {
#pragma unroll
            for (int j = 0; j < 8; ++j) mv[j] += pr[(size_t)sp * TAIL_ROWS * (DM / 4) + 64 * j]; }
        row6_finish(mv, xv, wp, wf, XN2 + (size_t)m * DM, MO + (size_t)m * DM, lane);
    }
}
struct Row9 { v2u h[8], y[8]; };
DI void row9_load(Row9& r, const Args& a, int i, int lane) {
    const GAS v2u* hr = (const GAS v2u*)((const bf16*)(a.ws + WS_MIXOUT) + (size_t)(NMETA + i) * DM) + lane; const GAS v2u* yr = (const GAS v2u*)((const bf16*)(a.ws + WS_XN) + (size_t)(NMETA + i) * DM) + lane;
#pragma unroll
    for (int j = 0; j < 8; ++j) { r.h[j] = hr[64 * j]; r.y[j] = yr[64 * j]; }
}
DI void row9_finish(const v2u (&hp)[8], const f32x4 (&yv)[8], const f32x4 (&wq)[8], float* orow, int lane) {
    const float rstd2 = __builtin_amdgcn_rsqf(wave_sum(sumsq8(yv)) * (1.f / DM) + EPS);
    GAS f32x4* o4 = (GAS f32x4*)orow + lane;
#pragma unroll
    for (int j = 0; j < 8; ++j) o4[64 * j] = bf4(hp[j]) + yv[j] * rstd2 * wq[j];
}
DI void p9_rows(const Args& a, LAS unsigned char* lds, int tid, int gw, int NGW, int lane) {
    f32x4 wq[8];
#pragma unroll
    for (int j = 0; j < 8; ++j) wq[j] = ((const GAS f32x4*)a.in[19])[lane + 64 * j];
    constexpr int NMAIN = TAIL_ROW0 - NMETA;
    {
        Row9 A, B; int i = gw;
        if (i < NMAIN) row9_load(A, a, i, lane);
        for (; i < NMAIN; i += 2 * NGW) {
            const int i1 = i + NGW, i2 = i + 2 * NGW;
            if (i1 < NMAIN) row9_load(B, a, i1, lane);
            { f32x4 yv[8];
#pragma unroll
              for (int j = 0; j < 8; ++j) yv[j] = bf4(A.y[j]);
              row9_finish(A.h, yv, wq, a.out + O_YP + (size_t)i * DM, lane); }
            if (i1 >= NMAIN) break;
            if (i2 < NMAIN) row9_load(A, a, i2, lane);
            { f32x4 yv[8];
#pragma unroll
              for (int j = 0; j < 8; ++j) yv[j] = bf4(B.y[j]);
              row9_finish(B.h, yv, wq, a.out + O_YP + (size_t)i1 * DM, lane); }
        }
    }
    const bf16* MO = (const bf16*)(a.ws + WS_MIXOUT);
    for (int i = NMAIN + gw; i < SEQ + NSAMP; i += NGW) {
        const int m = i < SEQ ? NMETA + i : ROW_S + (i - SEQ);
        float* orow = i < SEQ ? a.out + O_YP + (size_t)i * DM : a.out + O_YS + (size_t)(i - SEQ) * DM;
        const GAS v2u* hr = (const GAS v2u*)(MO + (size_t)m * DM) + lane;
        const GAS f32x4* pr = (const GAS f32x4*)((const float*)(a.ws + WS_PART) + (size_t)(m - TAIL_ROW0) * DM) + lane;
        v2u hp[8]; f32x4 yv[8];
#pragma unroll
        for (int j = 0; j < 8; ++j) { hp[j] = hr[64 * j]; yv[j] = pr[64 * j]; }
#pragma unroll 1
        for (int sp = 1; sp < NSPLIT; ++sp) {
#pragma unroll
            for (int j = 0; j < 8; ++j) yv[j] += pr[(size_t)sp * TAIL_ROWS * (DM / 4) + 64 * j]; }
        row9_finish(hp, yv, wq, orow, lane);
    }
}

constexpr int L_KN = 0, L_QN = 17408, L_KB = 34816, L_VBT = 52224, L_KBGT = 70656, L_KDT = 89088, L_AM = 107520, L_TL = 124928, L_GC = 134144, L_RED = 134656  ;
constexpr int RS = 136;
constexpr int TS = 72;
constexpr int AS = 68;
constexpr int RAWS = 392;
DI int perm64(int t) { return (t & 32) + 8 * ((t >> 2) & 3) + 4 * ((t >> 4) & 1) + (t & 3); }
DI float wave_incl_scan(float v, int lane) {
#pragma unroll
    for (int o = 1; o < 64; o <<= 1) { const float n = __shfl_up(v, o); if (lane >= o) v += n; }
    return v;
}
struct PrepIn { v4u rv[7]; float wv[3]; float bb, aa; };
DI void prep_fetch(PrepIn& p, const Args& a, int item, int tid, int lane) {
    const int h = item / NCH, c = item % NCH, r0 = CH * c;
    const bf16* QKV = (const bf16*)(a.ws + WS_QKV); const float* BA = (const float*)(a.ws + WS_BA);
    const int cc = tid % 48, rb = tid / 48;
    const bf16* gsrc = QKV + (long)(r0 - 3 + rb) * QKVD + (cc >> 4) * GW + h * HD + (cc & 15) * 8;
#pragma unroll
    for (int i = 0; i < 7; ++i) { p.rv[i] = (v4u){0u, 0u, 0u, 0u};
        if (tid < 480 && rb + 10 * i < 67 && r0 - 3 + rb + 10 * i >= 0) p.rv[i] = *(const GAS v4u*)(gsrc + (long)(10 * i) * QKVD); }
#pragma unroll
    for (int i = 0; i < 3; ++i) { const int e = tid + 512 * i, tap = e / 384, ch = e % 384; p.wv[i] = a.in[10][(size_t)tap * QKVD + (ch >> 7) * GW + h * HD + (ch & 127)]; }
    const int row = r0 + lane; p.bb = 0.f; p.aa = 0.f;
    if (row < NPOS) { p.bb = BA[(size_t)row * 16 + h]; p.aa = BA[(size_t)row * 16 + 8 + h]; }
}
DI void gdn_prep_item(const Args& a, LAS unsigned char* lds, int item, int next_item, PrepIn& pin, int tid_in, int lane_in, int wave) {
    int tid = tid_in, lane = lane_in; asm volatile("" : "+v"(tid), "+v"(lane));
    const int h = item / NCH, c = item % NCH, r0 = CH * c;
    const bf16* QKV = (const bf16*)(a.ws + WS_QKV); const float* BA = (const float*)(a.ws + WS_BA);
    const bool dry = (a.sub & 512) != 0; const int stop = (a.sub >> 10) & 15;
    unsigned char* si = dry ? a.ws + 500 * MiB + (size_t)(item % 256) * SCANIN_ITEM : a.ws + WS_SCANIN + (size_t)item * SCANIN_ITEM;
    LAS bf16* KN = (LAS bf16*)(lds + L_KN); LAS bf16* QN = (LAS bf16*)(lds + L_QN); LAS bf16* KB = (LAS bf16*)(lds + L_KB);
    LAS bf16* VBT = (LAS bf16*)(lds + L_VBT); LAS bf16* KBGT = (LAS bf16*)(lds + L_KBGT); LAS bf16* KDT = (LAS bf16*)(lds + L_KDT);
    LAS float* AM = (LAS float*)(lds + L_AM); LAS bf16* TL = (LAS bf16*)(lds + L_TL); LAS float* GC = (LAS float*)(lds + L_GC); LAS float* RED = (LAS float*)(lds + L_RED);
    const int t = lane, row = r0 + t; const bool valid = row < NPOS;
    float beta = 0.f, g = 0.f;
    if (valid) { beta = sigmoidf_(pin.bb); g = -__expf(a.in[11][h]) * softplusf_(pin.aa + a.in[12][h]); }
    const float gc = wave_incl_scan(g, lane);
    const float gcl = __shfl(gc, 63);
    if (wave == 0) { GC[t] = gc; if (lane == 0 && !dry) ((float*)(a.ws + WS_GL))[item] = __expf(gcl); }
    {
        LAS bf16* RAW = (LAS bf16*)lds; LAS float* WCV = (LAS float*)(lds + L_AM);
        const int cc = tid % 48, rb = tid / 48;
#pragma unroll
        for (int i = 0; i < 7; ++i) { if (tid < 480 && rb + 10 * i < 67) *(LAS v4u*)(RAW + (rb + 10 * i) * RAWS + cc * 8) = pin.rv[i]; }
#pragma unroll
        for (int i = 0; i < 3; ++i) WCV[tid + 512 * i] = pin.wv[i];
    }
    if (next_item >= 0) prep_fetch(pin, a, next_item, tid, lane);
    LDS_SYNC();
    if (dry && stop == 1) return;
    {
        const LAS unsigned* RAWW = (const LAS unsigned*)lds; const LAS float* WCV = (const LAS float*)(lds + L_AM);
        const int t0 = 8 * wave, l = lane;
        float wq[4][2], wk[4][2], wvv[4][2];
#pragma unroll
        for (int i = 0; i < 4; ++i) { const f32x2_ a_ = *(const LAS f32x2_*)(WCV + i * 384 + 2 * l), b_ = *(const LAS f32x2_*)(WCV + i * 384 + 128 + 2 * l), c_ = *(const LAS f32x2_*)(WCV + i * 384 + 256 + 2 * l);
            wq[i][0] = a_[0]; wq[i][1] = a_[1]; wk[i][0] = b_[0]; wk[i][1] = b_[1]; wvv[i][0] = c_[0]; wvv[i][1] = c_[1]; }
        unsigned xq[11], xk[11], xv[11];
#pragma unroll
        for (int rr = 0; rr < 11; ++rr) { const LAS unsigned* rp = RAWW + (t0 + rr) * (RAWS / 2) + l; xq[rr] = rp[0]; xk[rr] = rp[64]; xv[rr] = rp[128]; }
        float qv[8][2], kv[8][2], vv[8][2];
#pragma unroll
        for (int j = 0; j < 8; ++j) {
            float aq0 = 0.f, aq1 = 0.f, ak0 = 0.f, ak1 = 0.f, av0 = 0.f, av1 = 0.f;
#pragma unroll
            for (int i = 0; i < 4; ++i) { aq0 += wq[i][0] * bflo(xq[j + i]); aq1 += wq[i][1] * bfhi(xq[j + i]); ak0 += wk[i][0] * bflo(xk[j + i]); ak1 += wk[i][1] * bfhi(xk[j + i]);
                av0 += wvv[i][0] * bflo(xv[j + i]); av1 += wvv[i][1] * bfhi(xv[j + i]); }
            qv[j][0] = siluf_(aq0); qv[j][1] = siluf_(aq1); kv[j][0] = siluf_(ak0); kv[j][1] = siluf_(ak1); vv[j][0] = siluf_(av0); vv[j][1] = siluf_(av1);
        }
        float ss[16];
#pragma unroll
        for (int j = 0; j < 8; ++j) { ss[2 * j] = qv[j][0] * qv[j][0] + qv[j][1] * qv[j][1]; ss[2 * j + 1] = kv[j][0] * kv[j][0] + kv[j][1] * kv[j][1]; }
#pragma unroll
        for (int w_ = 8, bit = 32; w_ >= 1; w_ >>= 1, bit >>= 1) { const bool up = (lane & bit) != 0;
#pragma unroll
            for (int i = 0; i < w_; ++i) { const float send = up ? ss[i] : ss[i + w_], keep = up ? ss[i + w_] : ss[i]; ss[i] = keep + __shfl_xor(send, bit); } }
        ss[0] += __shfl_xor(ss[0], 2); ss[0] += __shfl_xor(ss[0], 1);
        unsigned vbt[2][4], kbg[2][4], kdt[2][4];
        float pv0[2], pk0[2], pd0[2];
        const int ssb = __builtin_bit_cast(int, ss[0]), betab = __builtin_bit_cast(int, beta), gcb = __builtin_bit_cast(int, gc);
#pragma unroll
        for (int j = 0; j < 8; ++j) {
            const float sq = __builtin_bit_cast(float, __builtin_amdgcn_readlane(ssb, 8 * j)), sk = __builtin_bit_cast(float, __builtin_amdgcn_readlane(ssb, 8 * j + 4));
            const float rq = __builtin_amdgcn_rsqf(sq + EPS) * 0.08838834764831845f, rk = __builtin_amdgcn_rsqf(sk + EPS);
            const float bt = __builtin_bit_cast(float, __builtin_amdgcn_readlane(betab, t0 + j)), gt = __builtin_bit_cast(float, __builtin_amdgcn_readlane(gcb, t0 + j));
            const float eg = __expf(gt), ekd = __expf(gcl - gt);
            const float k0 = kv[j][0] * rk, k1 = kv[j][1] * rk;
            const int tt = t0 + j;
            ((LAS unsigned*)QN)[tt * (RS / 2) + l] = pk2(qv[j][0] * rq, qv[j][1] * rq);
            ((LAS unsigned*)KN)[tt * (RS / 2) + l] = pk2(k0, k1);
            ((LAS unsigned*)KB)[tt * (RS / 2) + l] = pk2(k0 * bt, k1 * bt);
            const float v0 = vv[j][0] * bt, v1 = vv[j][1] * bt, g0 = k0 * bt * eg, g1 = k1 * bt * eg, d0 = k0 * ekd, d1 = k1 * ekd;
            if ((j & 1) == 0) { pv0[0] = v0; pv0[1] = v1; pk0[0] = g0; pk0[1] = g1; pd0[0] = d0; pd0[1] = d1; }
            else { vbt[0][j >> 1] = pk2(pv0[0], v0); vbt[1][j >> 1] = pk2(pv0[1], v1); kbg[0][j >> 1] = pk2(pk0[0], g0); kbg[1][j >> 1] = pk2(pk0[1], g1); kdt[0][j >> 1] = pk2(pd0[0], d0); kdt[1][j >> 1] = pk2(pd0[1], d1); }
        }
        const int p_lo = perm64(t0), p_hi = perm64(t0 + 4);
#pragma unroll
        for (int c = 0; c < 2; ++c) { const int d = 2 * l + c;
            *(LAS v4u*)(VBT + d * TS + t0) = (v4u){vbt[c][0], vbt[c][1], vbt[c][2], vbt[c][3]};
            *(LAS v4u*)(KBGT + d * TS + t0) = (v4u){kbg[c][0], kbg[c][1], kbg[c][2], kbg[c][3]};
            *(LAS v2u*)(KDT + d * TS + p_lo) = (v2u){kdt[c][0], kdt[c][1]};
            *(LAS v2u*)(KDT + d * TS + p_hi) = (v2u){kdt[c][2], kdt[c][3]}; }
    }
    LDS_SYNC();
    if (dry && stop == 3) return;
    const int r = lane & 15, q = lane >> 4;
    {
        int tmt[3], tnt[3]; bool isl[3]; f32x4 acc[3]; bf16x8 af[3][4], bfr[3][4];
#pragma unroll
        for (int k = 0; k < 3; ++k) {
            const int idx = (wave + 8 * k < 20) ? wave + 8 * k : wave; isl[k] = idx < 10;
            int a_ = 0, b_ = isl[k] ? idx : idx - 10; while (b_ >= a_ + 1) { b_ -= a_ + 1; ++a_; }
            tmt[k] = isl[k] ? a_ : b_; tnt[k] = isl[k] ? b_ : a_;
            const LAS bf16* pa = (isl[k] ? KB : KN) + (16 * tmt[k] + r) * RS + 8 * q; const LAS bf16* pb = (isl[k] ? KN : QN) + (16 * tnt[k] + r) * RS + 8 * q;
#pragma unroll
            for (int s = 0; s < 4; ++s) { af[k][s] = *(const LAS bf16x8*)(pa + 32 * s); bfr[k][s] = *(const LAS bf16x8*)(pb + 32 * s); }
            acc[k] = (f32x4){0.f, 0.f, 0.f, 0.f};
        }
#pragma unroll
        for (int s = 0; s < 4; ++s)
#pragma unroll
            for (int k = 0; k < 3; ++k) acc[k] = mfma16(af[k][s], bfr[k][s], acc[k]);
#pragma unroll
        for (int k = 0; k < 3; ++k) {
            if (k == 2 && wave >= 4) break;
            const int cn = 16 * tnt[k] + r; const float gn = GC[cn];
            if (isl[k]) {
#pragma unroll
                for (int e = 0; e < 4; ++e) { const int i = 16 * tmt[k] + 4 * q + e; AM[i * AS + cn] = i > cn ? acc[k][e] * __expf(GC[i] - gn) : 0.f; }
            } else {
                float o[4];
#pragma unroll
                for (int e = 0; e < 4; ++e) { const int ck = 16 * tmt[k] + 4 * q + e; o[e] = cn >= ck ? acc[k][e] * __expf(gn - GC[ck]) : 0.f; }
                *(GAS v2u*)((bf16*)(si + SI_QK) + cn * 64 + 32 * (tmt[k] >> 1) + 8 * q + 4 * (tmt[k] & 1)) = (v2u){pk2(o[0], o[1]), pk2(o[2], o[3])};
            }
        }
        if (wave >= 4) {
            for (int z = wave - 4; z < 6; z += 4) {
                const int mt = z == 0 ? 1 : (z < 3 ? 2 : 3), nt = z == 0 ? 0 : (z < 3 ? z - 1 : z - 3);
                *(GAS v2u*)((bf16*)(si + SI_QK) + (16 * nt + r) * 64 + 32 * (mt >> 1) + 8 * q + 4 * (mt & 1)) = (v2u){0u, 0u};
            }
        }
    }
    LDS_SYNC();
    if (dry && stop == 4) return;
    LAS float* TF = (LAS float*)(lds + L_KN); LAS float* XF = (LAS float*)(lds + L_KB);
    if (wave < 3) {
        const int e = wave * 64 + lane, n = e & 15, p = (e >> 4) - 4;
        const bool diag = e < 64, act = e < 160;
        const int bi = diag ? (e >> 4) : (p == 0 ? 1 : (p < 3 ? 2 : 3)), bk = diag ? bi : (p == 0 ? 0 : (p < 3 ? p - 1 : p - 3));
        if (act) {
            const LAS float* arow = AM + (16 * bi) * AS + 16 * bi; const LAS float* rhs = AM + (16 * bi) * AS + 16 * bk + n;
            LAS float* dst = (diag ? TF : XF) + (16 * bi) * AS + 16 * bk + n;
            float rv[16];
#pragma unroll
            for (int i = 0; i < 16; ++i) rv[i] = diag ? (i == n ? 1.f : 0.f) : -rhs[i * AS];
            float t[16];
#pragma unroll
            for (int i = 0; i < 16; ++i) t[i] = 0.f;
#pragma unroll
            for (int i = 0; i < 16; ++i) {
                float a0 = rv[i], a1 = 0.f, a2 = 0.f, a3 = 0.f;
#pragma unroll
                for (int jc = 0; jc < (i + 3) / 4; ++jc) { const f32x4 av = *(const LAS f32x4*)(arow + i * AS + 4 * jc);
                    a0 -= av[0] * t[4 * jc]; a1 -= av[1] * t[4 * jc + 1]; a2 -= av[2] * t[4 * jc + 2]; a3 -= av[3] * t[4 * jc + 3]; }
                t[i] = (a0 + a1) + (a2 + a3);
                dst[i * AS] = t[i];
                if (diag) TL[(16 * bi + i) * TS + 16 * bi + n] = (bf16)f2bf(t[i]);
            }
        }
    } else {
        v4u kd[4];
#pragma unroll
        for (int k = 0; k < 4; ++k) { const int e = tid - 192 + 320 * k, ec = e < 1024 ? e : 1023; kd[k] = *(const LAS v4u*)(KDT + (ec >> 3) * TS + 8 * (ec & 7)); }
#pragma unroll
        for (int k = 0; k < 4; ++k) { const int e = tid - 192 + 320 * k; if (e < 1024) *(GAS v4u*)((bf16*)(si + SI_KD) + (e >> 3) * 64 + 8 * (e & 7)) = kd[k]; }
        v2u lo[4], hi[4]; float eg[4];
#pragma unroll
        for (int k = 0; k < 4; ++k) { const int e = tid - 192 + 320 * k, ec = e < 1024 ? e : 1023, cq = ec >> 4, s = (ec >> 2) & 3, qq = ec & 3;
            lo[k] = *(const LAS v2u*)(QN + cq * RS + 32 * s + 4 * qq); hi[k] = *(const LAS v2u*)(QN + cq * RS + 32 * s + 16 + 4 * qq); eg[k] = GC[cq]; }
#pragma unroll
        for (int k = 0; k < 4; ++k) { const int e = tid - 192 + 320 * k, cq = e >> 4, s = (e >> 2) & 3, qq = e & 3; const float g_ = __expf(eg[k]);
            v4u o; o.x = pk2(bflo(lo[k].x) * g_, bfhi(lo[k].x) * g_); o.y = pk2(bflo(lo[k].y) * g_, bfhi(lo[k].y) * g_); o.z = pk2(bflo(hi[k].x) * g_, bfhi(hi[k].x) * g_); o.w = pk2(bflo(hi[k].y) * g_, bfhi(hi[k].y) * g_);
            if (e < 1024) *(GAS v4u*)((bf16*)(si + SI_QG) + cq * 128 + 32 * s + 8 * qq) = o; }
    }
    LDS_SYNC();
    if (dry && stop == 5) return;
#pragma unroll
    for (int d = 1; d < 4; ++d) {
        const int nbk = 4 - d;
        for (int e = tid; e < 256 * nbk; e += NTHR) {
            const int b_ = e >> 8, m_ = (e >> 4) & 15, n_ = e & 15, i_ = d + b_, j_ = b_; float x0 = 0.f, x1 = 0.f;
            const LAS float* br = XF + (16 * i_ + m_) * AS + 16 * j_; const LAS float* tc = TF + (16 * j_) * AS + 16 * j_ + n_;
#pragma unroll
            for (int kk = 0; kk < 16 * d; kk += 4) { const f32x4 bv = *(const LAS f32x4*)(br + kk);
                x0 += bv[0] * tc[kk * AS] + bv[1] * tc[(kk + 1) * AS]; x1 += bv[2] * tc[(kk + 2) * AS] + bv[3] * tc[(kk + 3) * AS]; }
            const float x = x0 + x1;
            TF[(16 * i_ + m_) * AS + 16 * j_ + n_] = x; TL[(16 * i_ + m_) * TS + 16 * j_ + n_] = (bf16)f2bf(x);
        }
        LDS_SYNC();
    }
    if (dry && stop == 6) return;
    {
        const int ntw = wave & 3, m0 = 4 * (wave >> 2);
        bf16x8 tl[4][2], vb[2], kb[4][2], tb[2];
#pragma unroll
        for (int s = 0; s < 2; ++s) {
            vb[s] = *(const LAS bf16x8*)(VBT + (16 * wave + r) * TS + 32 * s + 8 * q); tb[s] = *(const LAS bf16x8*)(TL + (16 * ntw + r) * TS + 32 * s + 8 * q);
#pragma unroll
            for (int m = 0; m < 4; ++m) { tl[m][s] = *(const LAS bf16x8*)(TL + (16 * m + r) * TS + 32 * s + 8 * q); kb[m][s] = *(const LAS bf16x8*)(KBGT + (16 * (m0 + m) + r) * TS + 32 * s + 8 * q); }
        }
        f32x4 au[4], aw[4];
#pragma unroll
        for (int m = 0; m < 4; ++m) { au[m] = (f32x4){0.f, 0.f, 0.f, 0.f}; aw[m] = (f32x4){0.f, 0.f, 0.f, 0.f}; }
#pragma unroll
        for (int s = 0; s < 2; ++s)
#pragma unroll
            for (int m = 0; m < 4; ++m) { au[m] = mfma16(tl[m][s], vb[s], au[m]); aw[m] = mfma16(kb[m][s], tb[s], aw[m]); }
        bf16* ub = (bf16*)(si + SI_U) + (wave * 64 + lane) * 16;
        *(GAS v4u*)ub = (v4u){pk2(au[0][0], au[0][1]), pk2(au[0][2], au[0][3]), pk2(au[1][0], au[1][1]), pk2(au[1][2], au[1][3])};
        *(GAS v4u*)(ub + 8) = (v4u){pk2(au[2][0], au[2][1]), pk2(au[2][2], au[2][3]), pk2(au[3][0], au[3][1]), pk2(au[3][2], au[3][3])};
        bf16* wb = (bf16*)(si + SI_W) + (16 * ntw + r) * 128 + 8 * q + 32 * (m0 >> 1);
        *(GAS v4u*)wb = (v4u){pk2(-aw[0][0], -aw[0][1]), pk2(-aw[0][2], -aw[0][3]), pk2(-aw[1][0], -aw[1][1]), pk2(-aw[1][2], -aw[1][3])};
        *(GAS v4u*)(wb + 32) = (v4u){pk2(-aw[2][0], -aw[2][1]), pk2(-aw[2][2], -aw[2][3]), pk2(-aw[3][0], -aw[3][1]), pk2(-aw[3][2], -aw[3][3])};
    }
    LDS_SYNC();
}

constexpr int SCAN_SL = 2;
constexpr int SC_WS = 272, SC_KS = 144, SC_KOFF = 64 * SC_WS, SC_UOFF = SC_KOFF + 128 * SC_KS, SC_BUF = SC_UOFF + SCAN_SL * 2048;
constexpr int SC_OUT = 2 * SC_BUF, SC_OBUF = SCAN_SL * 6144, SC_GL = SC_OUT + 2 * SC_OBUF;
struct ScanSet { v4u r[9]; };
DI void scan_issue(ScanSet& s, const unsigned char* si, int lid, int dvs0, const unsigned char* pf, unsigned& pfd) {
#pragma unroll
    for (int j = 0; j < 9; ++j) {
        const unsigned char* p = j < 4 ? si + SI_W + (lid + 256 * j) * 16 : (j < 8 ? si + SI_KD + (lid + 256 * (j - 4)) * 16 : si + SI_U + dvs0 * 2048 + lid * 16);
        asm volatile("global_load_dwordx4 %0, %1, off" : "=v"(s.r[j]) : "v"(p) : "memory");
    }
    asm volatile("global_load_dword %0, %1, off" : "+v"(pfd) : "v"(pf) : "memory");
}
DI void scan_wait_put(ScanSet& s, LAS unsigned char* buf, int lid) {
    asm volatile("s_waitcnt vmcnt(31)" : "+v"(s.r[0]), "+v"(s.r[1]), "+v"(s.r[2]), "+v"(s.r[3]), "+v"(s.r[4]), "+v"(s.r[5]), "+v"(s.r[6]), "+v"(s.r[7]), "+v"(s.r[8]) :: "memory");
#pragma unroll
    for (int j = 0; j < 4; ++j) { const int e = lid + 256 * j; *(LAS v4u*)(buf + (e >> 4) * SC_WS + (e & 15) * 16) = s.r[j]; }
#pragma unroll
    for (int j = 4; j < 8; ++j) { const int e = lid + 256 * (j - 4); *(LAS v4u*)(buf + SC_KOFF + (e >> 3) * SC_KS + (e & 7) * 16) = s.r[j]; }
    *(LAS v4u*)(buf + SC_UOFF + lid * 16) = s.r[8];
}
DI void scan_step(f32x4 (&S)[8], LAS unsigned char* buf, LAS unsigned char* ob, float gl, int dvl, int lane) {
    const int r = lane & 15, q = lane >> 4;
    const int woff = r * SC_WS + 16 * q, koff = SC_KOFF + r * SC_KS + 16 * q;
    const v4u ua = *(const LAS v4u*)(buf + SC_UOFF + (dvl * 64 + lane) * 32), ub = *(const LAS v4u*)(buf + SC_UOFF + (dvl * 64 + lane) * 32 + 16);
    bf16x8 Wf[4][4], Kf[8][2];
#pragma unroll
    for (int s = 0; s < 4; ++s)
#pragma unroll
        for (int m = 0; m < 4; ++m) Wf[m][s] = *(const LAS bf16x8*)(buf + woff + 16 * m * SC_WS + 64 * s);
#pragma unroll
    for (int s = 0; s < 2; ++s)
#pragma unroll
        for (int m = 0; m < 8; ++m) Kf[m][s] = *(const LAS bf16x8*)(buf + koff + 16 * m * SC_KS + 64 * s);
    bf16x8 Sb[4];
#pragma unroll
    for (int s = 0; s < 4; ++s) Sb[s] = pack8(S[2 * s][0], S[2 * s][1], S[2 * s][2], S[2 * s][3], S[2 * s + 1][0], S[2 * s + 1][1], S[2 * s + 1][2], S[2 * s + 1][3]);
    f32x4 vn[4];
    vn[0] = (f32x4){bflo(ua.x), bfhi(ua.x), bflo(ua.y), bfhi(ua.y)}; vn[1] = (f32x4){bflo(ua.z), bfhi(ua.z), bflo(ua.w), bfhi(ua.w)};
    vn[2] = (f32x4){bflo(ub.x), bfhi(ub.x), bflo(ub.y), bfhi(ub.y)}; vn[3] = (f32x4){bflo(ub.z), bfhi(ub.z), bflo(ub.w), bfhi(ub.w)};
#pragma unroll
    for (int s = 0; s < 4; ++s)
#pragma unroll
        for (int m = 0; m < 4; ++m) vn[m] = mfma16(Wf[m][s], Sb[s], vn[m]);
#pragma unroll
    for (int m = 0; m < 8; ++m) S[m] = S[m] * gl;
    bf16x8 Vb[2];
#pragma unroll
    for (int s = 0; s < 2; ++s) Vb[s] = pack8(vn[2 * s][0], vn[2 * s][1], vn[2 * s][2], vn[2 * s][3], vn[2 * s + 1][0], vn[2 * s + 1][1], vn[2 * s + 1][2], vn[2 * s + 1][3]);
#pragma unroll
    for (int s = 0; s < 2; ++s)
#pragma unroll
        for (int m = 0; m < 8; ++m) S[m] = mfma16(Kf[m][s], Vb[s], S[m]);
    LAS unsigned char* o = ob + dvl * 6144 + lane * 16;
#pragma unroll
    for (int s = 0; s < 4; ++s) *(LAS bf16x8*)(o + s * 1024) = Sb[s];
#pragma unroll
    for (int s = 0; s < 2; ++s) *(LAS bf16x8*)(o + (4 + s) * 1024) = Vb[s];
}
DI void scan_store(const LAS unsigned char* ob, unsigned char* g, int sid) {
#pragma unroll
    for (int k = 0; k < SC_OBUF / 2048; ++k) *(GAS v4u*)(g + (sid + 128 * k) * 16) = *(const LAS v4u*)(ob + (sid + 128 * k) * 16);
}
#define SCAN_SYNC() do { asm volatile("s_waitcnt lgkmcnt(0)" ::: "memory"); __builtin_amdgcn_s_barrier(); asm volatile("" ::: "memory"); } while (0)
DI void gdn_scan(const Args& a, LAS unsigned char* lds, int sb, int wave, int tid, int lane, int c0, int c1) {
    const int h = sb % NH, dvs0 = (sb / NH) * SCAN_SL;
    const bool comp = wave < SCAN_SL, loader = wave >= 2 && wave < 6, storer = wave >= 6;
    const int lid = (wave - 2) * 64 + lane, sid = (wave - 6) * 64 + lane, n = c1 - c0;
    const float* GL = (const float*)(a.ws + WS_GL) + h * NCH;
    const unsigned char* si0 = a.ws + WS_SCANIN + ((size_t)h * NCH + c0) * SCANIN_ITEM;
    unsigned char* so0 = a.ws + WS_SCANOUT + ((size_t)c0 * NH + h) * SCANOUT_ITEM + (size_t)dvs0 * 6144;
    LAS float* GLs = (LAS float*)(lds + SC_GL);
    for (int i = tid; i < n; i += NTHR) GLs[i] = GL[c0 + i];
    asm volatile("s_waitcnt vmcnt(0)" ::: "memory");
    if (loader) {
        ScanSet A, B, C, D; unsigned pfd = 0u;
        const int pfo = lid < 64 ? (sb / NH) * 8192 + lid * 128 : (lid < 96 ? (int)SI_U + dvs0 * 2048 + (lid - 64) * 128 : (sb / NH) * 8192);
#define SCAN_PF(k) (si0 + (size_t)((k) + 7 < n ? (k) + 7 : n - 1) * SCANIN_ITEM + pfo)
        scan_issue(A, si0, lid, dvs0, SCAN_PF(-3), pfd); scan_issue(B, si0 + SCANIN_ITEM, lid, dvs0, SCAN_PF(-2), pfd); scan_issue(C, si0 + 2 * SCANIN_ITEM, lid, dvs0, SCAN_PF(-1), pfd); scan_issue(D, si0 + 3 * SCANIN_ITEM, lid, dvs0, SCAN_PF(0), pfd);
        scan_wait_put(A, lds, lid);
        SCAN_SYNC();
#define SCAN_LD(k, SETL, SETW) do { if ((k) < n) { const int kl_ = (k) + 4 < n ? (k) + 4 : n - 1; scan_issue(SETL, si0 + (size_t)kl_ * SCANIN_ITEM, lid, dvs0, SCAN_PF((k) + 1), pfd); \
        scan_wait_put(SETW, lds + (((k) + 1) & 1) * SC_BUF, lid); SCAN_SYNC(); } } while (0)
        for (int k = 0; k < n; k += 4) { SCAN_LD(k, A, B); SCAN_LD(k + 1, B, C); SCAN_LD(k + 2, C, D); SCAN_LD(k + 3, D, A); }
#undef SCAN_LD
#undef SCAN_PF
        asm volatile("s_waitcnt vmcnt(0)" : "+v"(A.r[0]), "+v"(B.r[0]), "+v"(C.r[0]), "+v"(D.r[0]), "+v"(pfd) :: "memory");
    } else if (comp) {
        const int r = lane & 15, q = lane >> 4, dvs = dvs0 + wave;
        float* sst = (float*)(a.ws + WS_SSTATE) + (size_t)h * HD * HD;
        f32x4 S[8];
#pragma unroll
        for (int m = 0; m < 8; ++m)
#pragma unroll
            for (int e = 0; e < 4; ++e) S[m][e] = c0 > 0 ? sst[(16 * m + 4 * q + e) * HD + 16 * dvs + r] : 0.f;
        asm volatile("s_waitcnt vmcnt(0)" ::: "memory");
        SCAN_SYNC();
        for (int k = 0; k < n; ++k) { scan_step(S, lds + (k & 1) * SC_BUF, lds + SC_OUT + (k & 1) * SC_OBUF, GLs[k], wave, lane); SCAN_SYNC(); }
        float* out = c1 < NCH ? sst : a.out + O_PGS + (size_t)h * HD * HD;
#pragma unroll
        for (int m = 0; m < 8; ++m)
#pragma unroll
            for (int e = 0; e < 4; ++e) out[(16 * m + 4 * q + e) * HD + 16 * dvs + r] = S[m][e];
    } else {
        SCAN_SYNC();
        for (int k = 0; k < n; ++k) { if (storer && k > 0) scan_store(lds + SC_OUT + ((k - 1) & 1) * SC_OBUF, so0 + (size_t)(k - 1) * NH * SCANOUT_ITEM, sid); SCAN_SYNC(); }
        if (storer) scan_store(lds + SC_OUT + ((n - 1) & 1) * SC_OBUF, so0 + (size_t)(n - 1) * NH * SCANOUT_ITEM, sid);
    }
}

constexpr int O_QGS = 272, O_QKS = 144, O_ZS = 272;
constexpr int O_QG = 0, O_QK = 64 * O_QGS, O_Z = O_QK + 64 * O_QKS, O_IN = O_Z + 64 * O_ZS;
constexpr int O_OT = 2 * O_IN, O_PART = O_OT + 64 * 272;
struct OutStage { v4u g0, g1, k0, z0, z1; v4u sb[4], vb[2]; };
DI void out_load(OutStage& s, const Args& a, int item, int tid, int lane, int dvs) {
    const int h = item / NCH, c = item % NCH;
    const unsigned char* si = a.ws + WS_SCANIN + (size_t)item * SCANIN_ITEM;
    const unsigned char* so = a.ws + WS_SCANOUT + ((size_t)c * NH + h) * SCANOUT_ITEM + (size_t)dvs * 6144;
    const bf16* Z = (const bf16*)(a.ws + WS_Z) + (size_t)CH * c * 1024 + h * HD;
    s.g0 = *(const GAS v4u*)(si + SI_QG + tid * 16); s.g1 = *(const GAS v4u*)(si + SI_QG + (tid + 512) * 16);
    s.k0 = *(const GAS v4u*)(si + SI_QK + tid * 16);
    s.z0 = *(const GAS v4u*)(Z + (size_t)(tid >> 4) * 1024 + (tid & 15) * 8); s.z1 = *(const GAS v4u*)(Z + (size_t)(32 + (tid >> 4)) * 1024 + (tid & 15) * 8);
#pragma unroll
    for (int i = 0; i < 4; ++i) s.sb[i] = *(const GAS v4u*)(so + (i * 64 + lane) * 16);
#pragma unroll
    for (int i = 0; i < 2; ++i) s.vb[i] = *(const GAS v4u*)(so + ((4 + i) * 64 + lane) * 16);
}
DI void out_put(const OutStage& s, LAS unsigned char* buf, int tid) {
    *(LAS v4u*)(buf + O_QG + (tid >> 4) * O_QGS + (tid & 15) * 16) = s.g0; *(LAS v4u*)(buf + O_QG + (32 + (tid >> 4)) * O_QGS + (tid & 15) * 16) = s.g1;
    *(LAS v4u*)(buf + O_QK + (tid >> 3) * O_QKS + (tid & 7) * 16) = s.k0;
    *(LAS v4u*)(buf + O_Z + (tid >> 4) * O_ZS + (tid & 15) * 16) = s.z0; *(LAS v4u*)(buf + O_Z + (32 + (tid >> 4)) * O_ZS + (tid & 15) * 16) = s.z1;
}
DI void out_item(const Args& a, LAS unsigned char* lds, LAS unsigned char* buf, LAS unsigned char* nbuf, const OutStage& cur, const OutStage& nxt, int item, int tid, int lane, int wave) {
    const int h = item / NCH, c = item % NCH, r = lane & 15, q = lane >> 4, dvs = wave;
    LAS float* PART = (LAS float*)(lds + O_PART);
    f32x4 o[4]; float ss[4][4];
    {
        bf16x8 Gf[4][4], Qf[4][2];
#pragma unroll
        for (int s = 0; s < 4; ++s)
#pragma unroll
            for (int m = 0; m < 4; ++m) Gf[m][s] = *(const LAS bf16x8*)(buf + O_QG + (16 * m + r) * O_QGS + 64 * s + 16 * q);
#pragma unroll
        for (int s = 0; s < 2; ++s)
#pragma unroll
            for (int m = 0; m < 4; ++m) Qf[m][s] = *(const LAS bf16x8*)(buf + O_QK + (16 * m + r) * O_QKS + 64 * s + 16 * q);
#pragma unroll
        for (int m = 0; m < 4; ++m) o[m] = (f32x4){0.f, 0.f, 0.f, 0.f};
#pragma unroll
        for (int s = 0; s < 4; ++s)
#pragma unroll
            for (int m = 0; m < 4; ++m) o[m] = mfma16(Gf[m][s], __builtin_bit_cast(bf16x8, cur.sb[s]), o[m]);
#pragma unroll
        for (int s = 0; s < 2; ++s)
#pragma unroll
            for (int m = 0; m < 4; ++m) o[m] = mfma16(Qf[m][s], __builtin_bit_cast(bf16x8, cur.vb[s]), o[m]);
    }
#pragma unroll
    for (int m = 0; m < 4; ++m)
#pragma unroll
        for (int e = 0; e < 4; ++e) ss[m][e] = o[m][e] * o[m][e];
#pragma unroll
    for (int st_ = 1; st_ < 16; st_ <<= 1)
#pragma unroll
        for (int m = 0; m < 4; ++m)
#pragma unroll
            for (int e = 0; e < 4; ++e) ss[m][e] += __shfl_xor(ss[m][e], st_);
    if (r == 0) {
#pragma unroll
        for (int m = 0; m < 4; ++m)
#pragma unroll
            for (int e = 0; e < 4; ++e) PART[wave * 64 + 16 * m + 4 * q + e] = ss[m][e]; }
    LDS_SYNC();
    const int dv = 16 * dvs + r; const float nw = a.in[13][dv];
#pragma unroll
    for (int m = 0; m < 4; ++m)
#pragma unroll
        for (int e = 0; e < 4; ++e) { const int tk = 16 * m + 4 * q + e; float tot = 0.f;
#pragma unroll
            for (int w = 0; w < 8; ++w) tot += PART[w * 64 + tk];
            const float rstd = __builtin_amdgcn_rsqf(tot * (1.f / HD) + EPS);
            const float z = bf2f(*(const LAS bf16*)(buf + O_Z + tk * O_ZS + dv * 2));
            *(LAS bf16*)(lds + O_OT + tk * 272 + dv * 2) = (bf16)f2bf(o[m][e] * rstd * nw * siluf_(z)); }
    out_put(nxt, nbuf, tid);
    LDS_SYNC();
    bf16* MIX = (bf16*)(a.ws + WS_XN) + (size_t)CH * c * DM + h * HD;
    *(GAS v4u*)(MIX + (size_t)(tid >> 4) * DM + (tid & 15) * 8) = *(const LAS v4u*)(lds + O_OT + (tid >> 4) * 272 + (tid & 15) * 16);
    *(GAS v4u*)(MIX + (size_t)(32 + (tid >> 4)) * DM + (tid & 15) * 8) = *(const LAS v4u*)(lds + O_OT + (32 + (tid >> 4)) * 272 + (tid & 15) * 16);
}
DI void gdn_out_phase(const Args& a, LAS unsigned char* lds, int b, int nb, int c_lo, int c_hi, int tid, int lane, int wave) {
    const int nj = 8 * (c_hi - c_lo);
    if (b >= nj) return;
#define OUT_ITEM(j) (((j) & 7) * NCH + c_lo + ((j) >> 3))
    OutStage A, B;
    out_load(A, a, OUT_ITEM(b), tid, lane, wave);
    out_put(A, lds, tid);
    LDS_SYNC();
    for (int j = b; j < nj; j += 2 * nb) {
        const int n1 = j + nb, n2 = j + 2 * nb;
        out_load(B, a, OUT_ITEM(n1 < nj ? n1 : j), tid, lane, wave);
        out_item(a, lds, lds, lds + O_IN, A, B, OUT_ITEM(j), tid, lane, wave);
        if (n1 >= nj) break;
        out_load(A, a, OUT_ITEM(n2 < nj ? n2 : n1), tid, lane, wave);
        out_item(a, lds, lds + O_IN, lds, B, A, OUT_ITEM(n1), tid, lane, wave);
    }
#undef OUT_ITEM
    LDS_SYNC();
}

constexpr int S_QS = 0, S_KS = 1024, S_VS = 2048, S_US = 3072, S_KK = 4096, S_QK = 4160, S_GC = 4224, S_BE = 4232, S_GR = 4240, S_SSQ = 4248, S_RED = 4352, S_AQ = 6400, S_KT = 7424, S_XR = 7936  , S_WC = S_XR + 11 * 384  , S_END = S_WC + 4 * 384;
DI int aq_pos(int dk) { return ((dk >> 2) & 3) * 32 + (dk >> 5) * 8 + ((dk >> 4) & 1) * 4 + (dk & 3); }
DI void gdn_sample_item(const Args& a, LAS unsigned char* lds, int item, int tid_in, int lane_in, int wave) {
    int tid = tid_in, lane = lane_in; asm volatile("" : "+v"(tid), "+v"(lane));
    const int b = item >> 3, h = item & 7, R0 = ROW_S + 8 * b, r = lane & 15, q = lane >> 4, dvw = 16 * wave + r;
    LAS float* L = (LAS float*)lds; LAS bf16* AQ = (LAS bf16*)(L + S_AQ); LAS bf16* KT = (LAS bf16*)(L + S_KT);
    const bf16* QKV = (const bf16*)(a.ws + WS_QKV); const float* BA = (const float*)(a.ws + WS_BA);
    const float* hist = a.in[4] + (size_t)b * 3 * QKVD;
    const float* S0 = a.in[5] + ((size_t)(b * NH + h) * HD) * HD + dvw;
    f32x4 s0[8];
#pragma unroll
    for (int mt = 0; mt < 8; ++mt)
#pragma unroll
        for (int e = 0; e < 4; ++e) s0[mt][e] = __builtin_nontemporal_load(S0 + (size_t)(16 * mt + 4 * q + e) * HD);
    float zv[8];
#pragma unroll
    for (int i = 0; i < 8; ++i) zv[i] = bf2f(((const bf16*)(a.ws + WS_Z))[(size_t)(R0 + i) * 1024 + h * HD + dvw]);
    if (tid < 8) {
        const float bb = BA[(size_t)(R0 + tid) * 16 + h], aa = BA[(size_t)(R0 + tid) * 16 + 8 + h];
        L[S_BE + tid] = sigmoidf_(bb); L[S_GR + tid] = -__expf(a.in[11][h]) * softplusf_(aa + a.in[12][h]);
    }
    {
        const int ta = tid < 384 ? tid : 383, tb = tid < 288 ? tid : 287;
        const int t = ta / 48, rem = ta % 48, part = rem >> 4, pc = rem & 15;
        const int hrow = tb / 96, hrem = tb % 96, hpart = hrem >> 5, hpc = hrem & 31;
        const int tap = ta / 96, wrem = ta % 96, wpart = wrem >> 5, wpc = wrem & 31;
        const v4u w = *(const GAS v4u*)(QKV + (size_t)(R0 + t) * QKVD + part * GW + h * HD + 8 * pc);
        const f32x4 hv = *(const GAS f32x4*)(hist + (size_t)hrow * QKVD + hpart * GW + h * HD + 4 * hpc);
        const f32x4 wv = *(const GAS f32x4*)(a.in[10] + (size_t)tap * QKVD + wpart * GW + h * HD + 4 * wpc);
        const f32x4 lo = {bflo(w.x), bfhi(w.x), bflo(w.y), bfhi(w.y)}, hi = {bflo(w.z), bfhi(w.z), bflo(w.w), bfhi(w.w)};
        if (tid < 384) {
            LAS float* d = L + S_XR + (3 + t) * 384 + part * 128 + 8 * pc; *(LAS f32x4*)d = lo; *(LAS f32x4*)(d + 4) = hi;
            *(LAS f32x4*)(L + S_WC + tap * 384 + wpart * 128 + 4 * wpc) = wv;
            if (t >= 5) { float* og = a.out + O_SGC + ((size_t)b * 3 + (t - 5)) * QKVD + part * GW + h * HD + 8 * pc; *(GAS f32x4*)og = lo; *(GAS f32x4*)(og + 4) = hi; }
        }
        if (tid < 288) *(LAS f32x4*)(L + S_XR + hrow * 384 + hpart * 128 + 4 * hpc) = hv;
    }
    LDS_SYNC();
    {
        const int t = wave; float vals[6];
#pragma unroll
        for (int p = 0; p < 6; ++p) {
            const int c = (p >> 1) * 128 + lane + 64 * (p & 1); float acc = 0.f;
#pragma unroll
            for (int i = 0; i < 4; ++i) acc += L[S_WC + i * 384 + c] * L[S_XR + (t + i) * 384 + c];
            vals[p] = siluf_(acc);
        }
        const float sq = wave_sum(vals[0] * vals[0] + vals[1] * vals[1]), sk = wave_sum(vals[2] * vals[2] + vals[3] * vals[3]);
        const float rq = 1.f / sqrtf(sq + EPS) * 0.08838834764831845f, rk = 1.f / sqrtf(sk + EPS);
        const float q0 = vals[0] * rq, q1 = vals[1] * rq, k0 = vals[2] * rk, k1 = vals[3] * rk;
        L[S_QS + t * 128 + lane] = q0; L[S_QS + t * 128 + lane + 64] = q1;
        L[S_KS + t * 128 + lane] = k0; L[S_KS + t * 128 + lane + 64] = k1;
        L[S_VS + t * 128 + lane] = vals[4]; L[S_VS + t * 128 + lane + 64] = vals[5];
        AQ[(8 + t) * 128 + aq_pos(lane)] = (bf16)f2bf(q0); AQ[(8 + t) * 128 + aq_pos(lane + 64)] = (bf16)f2bf(q1);
        KT[lane * 8 + t] = (bf16)f2bf(k0); KT[(lane + 64) * 8 + t] = (bf16)f2bf(k1);
    }
    LDS_SYNC();
    float gc[8];
    { float s = 0.f;
#pragma unroll
      for (int i = 0; i < 8; ++i) { s += L[S_GR + i]; gc[i] = s; } }
    {
        const int p = tid >> 2, qd = tid & 3, i = (p & 63) >> 3, j = p & 7;
        const LAS float* x = L + (p < 64 ? S_KS : S_QS) + i * 128 + 32 * qd; const LAS float* y = L + S_KS + j * 128 + 32 * qd; float s = 0.f;
#pragma unroll
        for (int d = 0; d < 32; d += 4) { const f32x4 xa = *(const LAS f32x4*)(x + d), ya = *(const LAS f32x4*)(y + d); s += (xa[0] * ya[0] + xa[1] * ya[1]) + (xa[2] * ya[2] + xa[3] * ya[3]); }
        s += __shfl_xor(s, 1); s += __shfl_xor(s, 2);
        float gi = 0.f, gj = 0.f;
#pragma unroll
        for (int k = 0; k < 8; ++k) { gi = k == i ? gc[k] : gi; gj = k == j ? gc[k] : gj; }
        const float dec = j <= i ? __expf(gi - gj) : 0.f;
        if (qd == 0) L[(p < 64 ? S_KK : S_QK) + (p & 63)] = s * dec * (p < 64 ? L[S_BE + i] : 1.f);
        if (p >= 64 && i == j && qd == 0) L[S_GC + i] = gi;
    }
    LDS_SYNC();
    if (tid < 256) {
        const int col = tid & 127; const bool isw = tid >= 128; float sol[8];
        const int wpos = aq_pos(col);
#pragma unroll
        for (int i = 0; i < 8; ++i) {
            const float bi = L[S_BE + i];
            float v = isw ? bi * __expf(gc[i]) * L[S_KS + i * 128 + col] : bi * L[S_VS + i * 128 + col];
#pragma unroll
            for (int j = 0; j < i; ++j) v -= L[S_KK + i * 8 + j] * sol[j];
            sol[i] = v;
            if (isw) AQ[i * 128 + wpos] = (bf16)f2bf(v); else L[S_US + i * 128 + col] = v;
        }
    }
    LDS_SYNC();
    {
        f32x4 acc = {0.f, 0.f, 0.f, 0.f};
#pragma unroll
        for (int s = 0; s < 4; ++s) {
            const bf16x8 af = *(const LAS bf16x8*)(AQ + r * 128 + q * 32 + s * 8);
            const bf16x8 sb = pack8(s0[2 * s][0], s0[2 * s][1], s0[2 * s][2], s0[2 * s][3], s0[2 * s + 1][0], s0[2 * s + 1][1], s0[2 * s + 1][2], s0[2 * s + 1][3]);
            acc = mfma16(af, sb, acc);
        }
#pragma unroll
        for (int e = 0; e < 4; ++e) L[S_RED + (4 * q + e) * 128 + dvw] = acc[e];
    }
    LDS_SYNC();
    float vnew[8], o[8];
#pragma unroll
    for (int i = 0; i < 8; ++i) {
        vnew[i] = L[S_US + i * 128 + dvw] - L[S_RED + i * 128 + dvw];
        float oo = L[S_RED + (8 + i) * 128 + dvw] * __expf(gc[i]);
#pragma unroll
        for (int j = 0; j <= i; ++j) oo += L[S_QK + i * 8 + j] * vnew[j];
        o[i] = oo;
    }
    {
        float* Sout = a.out + O_SGS + ((size_t)(b * NH + h) * HD) * HD + dvw;
        const float egl = __expf(gc[7]);
        float vd[8];
#pragma unroll
        for (int i = 0; i < 8; ++i) vd[i] = q == 0 ? __expf(gc[7] - gc[i]) * vnew[i] : 0.f;
        const bf16x8 vb = pack8(vd[0], vd[1], vd[2], vd[3], vd[4], vd[5], vd[6], vd[7]);
#pragma unroll
        for (int mt = 0; mt < 8; ++mt) {
            bf16x8 kf = *(const LAS bf16x8*)(KT + (16 * mt + r) * 8);
            if (q != 0) kf = (bf16x8){0, 0, 0, 0, 0, 0, 0, 0};
            const f32x4 sn = mfma16(kf, vb, s0[mt] * egl);
#pragma unroll
            for (int e = 0; e < 4; ++e) __builtin_nontemporal_store(sn[e], Sout + (size_t)(16 * mt + 4 * q + e) * HD);
        }
    }
#pragma unroll
    for (int i = 0; i < 8; ++i) { const float s = wave_sum(q == 0 ? o[i] * o[i] : 0.f); if (lane == 0) L[S_SSQ + wave * 8 + i] = s; }
    LDS_SYNC();
    if (q == 0) {
        bf16* MIX = (bf16*)(a.ws + WS_XN); const float nw = a.in[13][dvw];
#pragma unroll
        for (int i = 0; i < 8; ++i) { float tot = 0.f;
#pragma unroll
            for (int w = 0; w < 8; ++w) tot += L[S_SSQ + w * 8 + i];
            const float rstd = 1.f / sqrtf(tot * (1.f / HD) + EPS);
            MIX[((size_t)R0 + i) * DM + h * HD + dvw] = (bf16)f2bf(o[i] * rstd * nw * siluf_(zv[i])); }
    }
    LDS_SYNC();
}

DI void vt_item(const Args& a, LAS unsigned char* lds, int blk, int tid) {
    const bf16* SQ = (const bf16*)(a.ws + WS_SQKV); bf16* VT = (bf16*)(a.ws + WS_VT);
    LAS bf16* T = (LAS bf16*)lds;
    const int p0 = 64 * blk;
    { const int rr = tid >> 3, cc = tid & 7;
        const GAS v4u* src = (const GAS v4u*)(SQ + (size_t)(p0 + rr) * SQKV_LD + 1280 + 32 * cc);
#pragma unroll
        for (int i = 0; i < 4; ++i) *(LAS v4u*)(T + rr * 264 + 32 * cc + 8 * i) = src[i]; }
    LDS_SYNC();
    { const int ch = tid >> 1, hf = tid & 1;
        unsigned w[16];
#pragma unroll
        for (int i = 0; i < 16; ++i) w[i] = (unsigned)T[(32 * hf + 2 * i) * 264 + ch] | ((unsigned)T[(32 * hf + 2 * i + 1) * 264 + ch] << 16);
        GAS v4u* dst = (GAS v4u*)(VT + (size_t)ch * VT_LD + p0 + 32 * hf);
#pragma unroll
        for (int i = 0; i < 4; ++i) dst[i] = (v4u){w[4 * i], w[4 * i + 1], w[4 * i + 2], w[4 * i + 3]}; }
    LDS_SYNC();
}
DI void kv_outputs(const Args& a, size_t gt, size_t NGT) {
    const bf16* SQ = (const bf16*)(a.ws + WS_SQKV); const bf16* QKV = (const bf16*)(a.ws + WS_QKV);
    for (size_t e = gt; e < 16 * 512; e += NGT) { const int pos = (int)(e >> 9), kv = (int)(e >> 8) & 1, c = (int)(e & 255);
        a.out[O_PMETA + e] = bf2f(SQ[(size_t)pos * SQKV_LD + 1024 + 256 * kv + c]); }
    for (size_t e = gt; e < 128 * 512; e += NGT) { const int pos = NPOS - 128 + (int)(e >> 9), kv = (int)(e >> 8) & 1, c = (int)(e & 255);
        a.out[O_PWIN + e] = bf2f(SQ[(size_t)pos * SQKV_LD + 1024 + 256 * kv + c]); }
    for (size_t e = gt; e < 3 * QKVD; e += NGT) { const int i = (int)(e / QKVD), c = (int)(e % QKVD);
        a.out[O_PGC + e] = bf2f(QKV[(size_t)(NPOS - 3 + i) * QKVD + c]); }
}
DI void swin_output(const Args& a, size_t gt, size_t NGT) {
    const bf16* SQ = (const bf16*)(a.ws + WS_SQKV);
    for (size_t e = gt; e < (size_t)DBATCH * 128 * 512 / 4; e += NGT) {
        const size_t e4 = e * 4; const int b = (int)(e4 >> 16), j = (int)(e4 >> 9) & 127, kv = (int)(e4 >> 8) & 1, c = (int)(e4 & 255);
        f32x4 v;
        if (j < 120) v = *(const GAS f32x4*)(a.in[3] + ((size_t)b * 128 + j + 8) * 512 + 256 * kv + c);
        else { const v2u w = *(const GAS v2u*)(SQ + (size_t)(ROW_S + 8 * b + (j - 120)) * SQKV_LD + 1024 + 256 * kv + c); v = (f32x4){bflo(w.x), bfhi(w.x), bflo(w.y), bfhi(w.y)}; }
        *(GAS f32x4*)(a.out + O_SWIN + e4) = v;
    }
}

DI int crow(int reg, int hh) { return (reg & 3) + 8 * (reg >> 2) + 4 * hh; }
constexpr int PK_RS = 272, PV_RS = 72;
constexpr int P_KOFF = 0, P_VOFF = 64 * PK_RS, P_BUF = P_VOFF + 256 * PV_RS;
struct SwaStage { v4u k[2], v[2]; };
DI void swa_stage_load(SwaStage& s, const bf16* SQ, const bf16* VT, int k0, int tid) {
#pragma unroll
    for (int j = 0; j < 2; ++j) { const int e = tid + 512 * j;
        s.k[j] = *(const GAS v4u*)(SQ + (size_t)(k0 + ((e >> 4) & 31)) * SQKV_LD + 1024 + (e >> 9) * HD + 8 * (e & 15));
        s.v[j] = *(const GAS v4u*)(VT + (size_t)((e >> 9) * HD + ((e >> 2) & 127)) * VT_LD + k0 + 8 * (e & 3)); }
}
DI void swa_stage_put(const SwaStage& s, LAS unsigned char* buf, int tid) {
#pragma unroll
    for (int j = 0; j < 2; ++j) { const int e = tid + 512 * j;
        *(LAS v4u*)(buf + P_KOFF + ((e >> 9) * 32 + ((e >> 4) & 31)) * PK_RS + 16 * (e & 15)) = s.k[j];
        LAS unsigned char* vp = buf + P_VOFF + ((e >> 9) * HD + ((e >> 2) & 127)) * PV_RS + 16 * (e & 3);
        *(LAS v2u*)vp = (v2u){s.v[j].x, s.v[j].y}; *(LAS v2u*)(vp + 8) = (v2u){s.v[j].z, s.v[j].w}; }
}
DI void swa_prompt_block(const Args& a, LAS unsigned char* lds, LAS float* btab  , const LAS int* bucket, int qt, int tid_in, int lane_in, int wave) {
    int tid = tid_in, lane = lane_in; asm volatile("" : "+v"(tid), "+v"(lane));
    const bf16* SQ = (const bf16*)(a.ws + WS_SQKV); const bf16* VT = (const bf16*)(a.ws + WS_VT); bf16* MIX = (bf16*)(a.ws + WS_XN);
    const int head = wave, kvh = head >> 2, p0 = 32 * qt, ql = lane & 31, hh = lane >> 5, qpos = p0 + ql;
    for (int d = lane; d < 129; d += 64) btab[d] = a.in[8][(d < 128 ? bucket[d] : 31) * NH + head];
    bf16x8 Qf[8];
#pragma unroll
    for (int s = 0; s < 8; ++s) Qf[s] = *(const GAS bf16x8*)(SQ + (size_t)qpos * SQKV_LD + head * HD + 64 * hh + 8 * s);
    const float sink = a.in[14][head];
    float m = sink, l = hh == 0 ? 1.f : 0.f;
    f32x16 O[4];
#pragma unroll
    for (int mt = 0; mt < 4; ++mt)
#pragma unroll
        for (int e = 0; e < 16; ++e) O[mt][e] = 0.f;
    const float scale = 0.08838834764831845f;
    const int t1 = p0 >= 128 ? 1 : 1 + (128 - p0) / 32;
    SwaStage st;
    swa_stage_load(st, SQ, VT, 0, tid);
    swa_stage_put(st, lds, tid);
    LDS_SYNC();
    int par = 0;
    for (int ti = 0; ti < 6; ti = (ti == 0 ? t1 : ti + 1)) {
        const int k0 = ti == 0 ? 0 : p0 - 128 + 32 * (ti - 1);
        const int tn = ti == 0 ? t1 : ti + 1, k0n = tn < 6 ? p0 - 128 + 32 * (tn - 1) : k0;
        swa_stage_load(st, SQ, VT, k0n, tid);
        const LAS unsigned char* buf = lds + par * P_BUF;
        const LAS unsigned char* kb = buf + P_KOFF + (kvh * 32 + ql) * PK_RS + 128 * hh;
        f32x16 St;
#pragma unroll
        for (int e = 0; e < 16; ++e) St[e] = 0.f;
#pragma unroll
        for (int s = 0; s < 8; ++s) St = mfma32(*(const LAS bf16x8*)(kb + 16 * s), Qf[s], St);
        float sc[16]; float mx = -INFINITY;
#pragma unroll
        for (int e = 0; e < 16; ++e) { const int kpos = k0 + crow(e, hh), dist = qpos - kpos;
            const bool ok = ti == 0 ? (kpos < NMETA && dist >= 0) : (kpos >= NMETA && dist >= 0 && dist < WIN);
            const float bias = btab[dist < 0 ? 0 : (dist > 128 ? 128 : dist)];
            sc[e] = ok ? St[e] * scale + bias : -INFINITY; mx = fmaxf(mx, sc[e]); }
        mx = fmaxf(mx, __shfl_xor(mx, 32));
        const float mn = fmaxf(m, mx), alpha = __expf(m - mn); m = mn;
        float ps = 0.f; float p[16];
#pragma unroll
        for (int e = 0; e < 16; ++e) { p[e] = __expf(sc[e] - mn); ps += p[e]; }
        l = l * alpha + ps;
#pragma unroll
        for (int mt = 0; mt < 4; ++mt)
#pragma unroll
            for (int e = 0; e < 16; ++e) O[mt][e] *= alpha;
        bf16x8 Pb[2];
#pragma unroll
        for (int s = 0; s < 2; ++s) Pb[s] = pack8(p[8 * s], p[8 * s + 1], p[8 * s + 2], p[8 * s + 3], p[8 * s + 4], p[8 * s + 5], p[8 * s + 6], p[8 * s + 7]);
#pragma unroll
        for (int mt = 0; mt < 4; ++mt)
#pragma unroll
            for (int s = 0; s < 2; ++s) {
                const LAS unsigned char* vp = buf + P_VOFF + (kvh * HD + 32 * mt + ql) * PV_RS + 32 * s + 8 * hh;
                const v2u lo = *(const LAS v2u*)vp, hi = *(const LAS v2u*)(vp + 16);
                const v4u vv = {lo.x, lo.y, hi.x, hi.y};
                O[mt] = mfma32(__builtin_bit_cast(bf16x8, vv), Pb[s], O[mt]);
            }
        swa_stage_put(st, lds + (par ^ 1) * P_BUF, tid);
        par ^= 1;
        LDS_SYNC();
    }
    l += __shfl_xor(l, 32);
    const float inv = 1.f / l;
    LAS unsigned char* ow = lds + wave * (32 * 272);
#pragma unroll
    for (int mt = 0; mt < 4; ++mt)
#pragma unroll
        for (int g = 0; g < 4; ++g) *(LAS v2u*)(ow + ql * 272 + (32 * mt + 8 * g + 4 * hh) * 2) = (v2u){pk2(O[mt][4 * g] * inv, O[mt][4 * g + 1] * inv), pk2(O[mt][4 * g + 2] * inv, O[mt][4 * g + 3] * inv)};
    asm volatile("s_waitcnt lgkmcnt(0)" ::: "memory");
#pragma unroll
    for (int j = 0; j < 8; ++j) { const int e = lane + 64 * j, rr = e >> 4, cc = e & 15;
        if (p0 + rr < NPOS) *(GAS v4u*)(MIX + (size_t)(p0 + rr) * DM + GW + head * HD + 8 * cc) = *(const LAS v4u*)(ow + rr * 272 + 16 * cc); }
    LDS_SYNC();
}

constexpr int A2_KRS = 272, A2_VOFF = 160 * A2_KRS, A2_VRS = 72, A2_VTILE = 128 * A2_VRS, A2_BR = A2_VOFF + 5 * A2_VTILE, A2_BRS = 161, A2_OW = A2_BR + 32 * A2_BRS * 4, A2_END = A2_OW + 32 * 272;
DI void swa_sample_item(const Args& a, LAS unsigned char* lds, const LAS int* bucket, int item, int tid_in, int lane_in, int wave) {
    int tid = tid_in, lane = lane_in; asm volatile("" : "+v"(tid), "+v"(lane));
    const int b = item >> 1, kvh = item & 1, R0 = ROW_S + 8 * b;
    const bf16* SQ = (const bf16*)(a.ws + WS_SQKV); bf16* MIX = (bf16*)(a.ws + WS_XN);
    LAS float* BR = (LAS float*)(lds + A2_BR);
#define SWA_FETCH_KV(kvr, which) { const int k0_ = tid >> 5, c4_ = (tid & 31) * 4; \
    kvr[0] = *(const GAS f32x4*)(a.in[2] + (((size_t)b * 16 + k0_) * 2 + (which)) * 256 + kvh * HD + c4_); \
    _Pragma("unroll") for (int i = 1; i < 9; ++i) kvr[i] = *(const GAS f32x4*)(a.in[3] + (((size_t)b * 128 + k0_ + 16 * i - 16) * 2 + (which)) * 256 + kvh * HD + c4_); \
    { const v2u w_ = *(const GAS v2u*)(SQ + (size_t)(R0 + (k0_ & 7)) * SQKV_LD + 1024 + 256 * (which) + kvh * HD + c4_); kvr[9] = (f32x4){bflo(w_.x), bfhi(w_.x), bflo(w_.y), bfhi(w_.y)}; } }
    f32x4 kreg[10], vreg[10];
    SWA_FETCH_KV(kreg, 0)
    SWA_FETCH_KV(vreg, 1)
#undef SWA_FETCH_KV
    float brv[10];
    { const int qi = tid & 31, kg = tid >> 5, g = qi >> 3, t = qi & 7, head = kvh * 4 + g;
#pragma unroll
      for (int n = 0; n < 10; ++n) { const int key = kg + 16 * n; bool ok; int bk;
          if (n == 0) { ok = true; bk = 31; }
          else if (n < 9) { const int j = key - 16; ok = j > t; const int dist = 128 + t - j; bk = dist >= 128 ? 31 : bucket[dist]; }
          else { const int t2 = key - 144; ok = t2 <= t && key < 152; bk = bucket[(t - t2 < 0 || t2 > 7) ? 0 : t - t2]; }
          const float bias = a.in[8][bk * NH + head];
          brv[n] = ok ? bias : -INFINITY; } }
    const int ql = lane & 31, hh = lane >> 5, qg = ql >> 3, qt = ql & 7, qhead = kvh * 4 + qg;
    bf16x8 Qf[8];
#pragma unroll
    for (int s = 0; s < 8; ++s) Qf[s] = *(const GAS bf16x8*)(SQ + (size_t)(R0 + qt) * SQKV_LD + qhead * HD + 64 * hh + 8 * s);
    const float sink = a.in[14][qhead];
    { const int k0_ = tid >> 5, c4 = (tid & 31) * 4, qi = tid & 31;
#pragma unroll
      for (int i = 0; i < 10; ++i) { const int key = k0_ + 16 * i; const bool real = key < 152;
          const f32x4 kk = real ? kreg[i] : (f32x4){0.f, 0.f, 0.f, 0.f}, vv = real ? vreg[i] : (f32x4){0.f, 0.f, 0.f, 0.f};
          *(LAS v2u*)(lds + key * A2_KRS + c4 * 2) = (v2u){pk2(kk[0], kk[1]), pk2(kk[2], kk[3])};
          LAS unsigned char* vb = lds + A2_VOFF + (key >> 5) * A2_VTILE + c4 * A2_VRS + (key & 31) * 2;
#pragma unroll
          for (int j = 0; j < 4; ++j) *(LAS bf16*)(vb + j * A2_VRS) = (bf16)f2bf(vv[j]);
          BR[qi * A2_BRS + key] = brv[i]; } }
    LDS_SYNC();
    if (wave < 4) {
        const int mt = wave; const float scale = 0.08838834764831845f;
        float m = sink, l = hh == 0 ? 1.f : 0.f;
        f32x16 O;
#pragma unroll
        for (int e = 0; e < 16; ++e) O[e] = 0.f;
        for (int tile = 0; tile < 5; ++tile) {
            const LAS unsigned char* kb = lds + (32 * tile + ql) * A2_KRS + 128 * hh;
            f32x16 St;
#pragma unroll
            for (int e = 0; e < 16; ++e) St[e] = 0.f;
#pragma unroll
            for (int s = 0; s < 8; ++s) St = mfma32(*(const LAS bf16x8*)(kb + 16 * s), Qf[s], St);
            float sc[16]; float mx = -INFINITY;
#pragma unroll
            for (int e = 0; e < 16; ++e) { sc[e] = St[e] * scale + BR[ql * A2_BRS + 32 * tile + crow(e, hh)]; mx = fmaxf(mx, sc[e]); }
            mx = fmaxf(mx, __shfl_xor(mx, 32));
            const float mn = fmaxf(m, mx), alpha = __expf(m - mn); m = mn;
            float ps = 0.f; float p[16];
#pragma unroll
            for (int e = 0; e < 16; ++e) { p[e] = __expf(sc[e] - mn); ps += p[e]; }
            l = l * alpha + ps;
#pragma unroll
            for (int e = 0; e < 16; ++e) O[e] *= alpha;
            bf16x8 Pb[2];
#pragma unroll
            for (int s = 0; s < 2; ++s) Pb[s] = pack8(p[8 * s], p[8 * s + 1], p[8 * s + 2], p[8 * s + 3], p[8 * s + 4], p[8 * s + 5], p[8 * s + 6], p[8 * s + 7]);
#pragma unroll
            for (int s = 0; s < 2; ++s) {
                const LAS unsigned char* vp = lds + A2_VOFF + tile * A2_VTILE + (32 * mt + ql) * A2_VRS + 32 * s + 8 * hh;
                const v2u lo = *(const LAS v2u*)vp, hi = *(const LAS v2u*)(vp + 16);
                const v4u vv = {lo.x, lo.y, hi.x, hi.y};
                O = mfma32(__builtin_bit_cast(bf16x8, vv), Pb[s], O);
            }
        }
        l += __shfl_xor(l, 32);
        const float inv = 1.f / l;
        LAS unsigned char* ow = lds + A2_OW;
#pragma unroll
        for (int g4 = 0; g4 < 4; ++g4) *(LAS v2u*)(ow + ql * 272 + (32 * mt + 8 * g4 + 4 * hh) * 2) = (v2u){pk2(O[4 * g4] * inv, O[4 * g4 + 1] * inv), pk2(O[4 * g4 + 2] * inv, O[4 * g4 + 3] * inv)};
    }
    LDS_SYNC();
    { const int rr = tid >> 4, cc = tid & 15;
      *(GAS v4u*)(MIX + (size_t)(R0 + (rr & 7)) * DM + GW + (kvh * 4 + (rr >> 3)) * HD + 8 * cc) = *(const LAS v4u*)(lds + A2_OW + rr * 272 + 16 * cc); }
    LDS_SYNC();
}

#ifndef MK_PER_PHASE
#define MK_PER_PHASE 0
#endif
constexpr int N_PHASES = 11;
#ifndef KA_ITEMS
#define KA_ITEMS 7
#endif
#ifndef SPL_CHUNKS
#define SPL_CHUNKS 193
#endif
constexpr int L_BUCKET = 139264, L_BTAB = 139776;


__global__ void __launch_bounds__(NTHR, 2) mega_fwd(Args args) {
    extern __shared__ __attribute__((aligned(16))) unsigned char lds_raw[];
    LAS unsigned char* lds = (LAS unsigned char*)lds_raw;
    const int tid_k = threadIdx.x, lane_k = tid_k & 63, wave = __builtin_amdgcn_readfirstlane(tid_k >> 6);
    const int tid = tid_k, lane = lane_k;
    const int G = gridDim.x, bid = blockIdx.x;
    const int gw = bid * NWAVES + wave, NGW = G * NWAVES;
    volatile LAS unsigned* MISC = (volatile LAS unsigned*)(lds + MISC_OFF);
    for (int u = tid; u < 64; u += NTHR) MISC[u] = 0u;
    __syncthreads();
    XcdBarrier bar; bar.bar = (unsigned*)(args.ws + WS_CTL) + CW_BAR; bar.x = 0; bar.st = nullptr;
    if (!MK_PER_PHASE) bar = xcd_barrier_post((unsigned*)(args.ws + WS_CTL) + CW_BAR, MISC + 8);
    const int lo = args.ph_lo, hi = args.ph_hi;
#ifndef PH_MASK
#define PH_MASK 0x7ff
#endif
#define IN(k) (((PH_MASK >> (k)) & 1) && lo <= (k) && (k) < hi)
#ifndef REP_MASK
#define REP_MASK 0
#endif
#define SEAM(k) do { if (IN(k) && IN((k) + 1)) xcd_barrier(bar); } while (0)

    if (IN(0)) { p0_prologue(args, lds, gw, NGW, lane, wave); }
    SEAM(0);
    if (IN(1)) {
        pg8::Gemm g{(const pg8::bf16_t*)(args.ws + WS_XN), (const pg8::bf16_t*)(args.ws + WS_WIN), MPAD / 256, NPROJ / 256, DM};
        pg8::StaticOrder S; S.init(g.nM, g.nN, G, bid, g.K / 64);
        EpiProj E{(bf16*)(args.ws + WS_QKV), (bf16*)(args.ws + WS_Z), (bf16*)(args.ws + WS_SQKV)};
        pg8::gemm_phase<EpiProj, pg8::AMapStd>(lds, g, S, E);
        if (!(args.sub & 128)) p1_ba(args, lds, bid, G, tid, lane, wave);
    }
    SEAM(1);
    if (IN(2)) {
        constexpr int N_PREP = NH * NCH, N_SAMP = DBATCH * NH, N_VT = 257;
        if (args.sub & 8) { PrepIn pin; prep_fetch(pin, args, bid, tid, lane);
            for (int e = tid; e < 64 * TS * 2 / 16; e += NTHR) *(LAS v4u*)(lds + L_TL + e * 16) = (v4u){0u, 0u, 0u, 0u};
            for (int it = bid; it < N_PREP; it += G) gdn_prep_item(args, lds, it, it + G < N_PREP ? it + G : -1, pin, tid, lane, wave); }
        if (args.sub & 32) { const int nvb = G - N_PREP % 256; for (int it = bid - N_PREP % 256; it >= 0 && it < N_VT; it += nvb) vt_item(args, lds, it, tid); }
        if (args.sub & 32) kv_outputs(args, (size_t)bid * NTHR + tid, (size_t)G * NTHR);
    }
    SEAM(2);
    constexpr int SCAN_BLOCKS = NH * 8 / SCAN_SL, SPL = SPL_CHUNKS;
    if (IN(3)) {
        if (bid < SCAN_BLOCKS) { if (args.sub & 1) gdn_scan(args, lds, bid, wave, tid, lane, 0, SPL); }
        else {
            LAS int* bucket = (LAS int*)(lds + L_BUCKET);
            if (tid < 128) { const int n_ = tid; int bk = n_;
                if (n_ >= 16) { const int lg = 16 + (int)(logf((float)n_ / 16.0f) / 2.0794415416798357f * 16.0f); bk = lg < 31 ? lg : 31; }
                bucket[tid] = bk; }
            __syncthreads();
            const int nb = G - SCAN_BLOCKS, b2 = bid - SCAN_BLOCKS;
            constexpr int N_PS = 513, N_SS = DBATCH * KVH, N_SG = DBATCH * NH, N_ALL = N_PS + N_SS + N_SG;
            LAS float* btab = (LAS float*)(lds + L_BTAB) + wave * 160;
            const bool rev = (b2 & 1) != 0;
            const int nit = (N_ALL - b2 + nb - 1) / nb, kmid = KA_ITEMS < nit ? KA_ITEMS : nit;
            if (args.sub & 32) { swin_output(args, (size_t)b2 * NTHR + tid, (size_t)nb * NTHR); p5_ffn_weights(args, lds, b2 * NWAVES + wave, nb * NWAVES, lane, wave, 0); p5_ffn_weights(args, lds, b2 * NWAVES + wave, nb * NWAVES, lane, wave, 1); p3_wout(args, lds, b2 * NWAVES + wave, nb * NWAVES, lane, wave); }
            __syncthreads();
            for (int k = 0; k < kmid; ++k) {
                const int it = b2 + (rev ? nit - 1 - k : k) * nb;
                if (it < N_PS) { if (args.sub & 4) swa_prompt_block(args, lds, btab, bucket, it, tid, lane, wave); }
                else if (it < N_PS + N_SS) { if (args.sub & 2) swa_sample_item(args, lds, bucket, it - N_PS, tid, lane, wave); }
                else { if (args.sub & 16) gdn_sample_item(args, lds, it - N_PS - N_SS, tid, lane, wave); }
            }
        }
    }
    SEAM(3);
    if (IN(4)) {
        if (bid < SCAN_BLOCKS) { if (args.sub & 1) gdn_scan(args, lds, bid, wave, tid, lane, SPL, NCH); }
        else {
            LAS int* bucket = (LAS int*)(lds + L_BUCKET);
            if (tid < 128) { const int n_ = tid; int bk = n_;
                if (n_ >= 16) { const int lg = 16 + (int)(logf((float)n_ / 16.0f) / 2.0794415416798357f * 16.0f); bk = lg < 31 ? lg : 31; }
                bucket[tid] = bk; }
            __syncthreads();
            const int nb = G - SCAN_BLOCKS, b2 = bid - SCAN_BLOCKS;
            constexpr int N_PS = 513, N_SS = DBATCH * KVH, N_SG = DBATCH * NH, N_ALL = N_PS + N_SS + N_SG;
            LAS float* btab = (LAS float*)(lds + L_BTAB) + wave * 160;
            const bool rev = (b2 & 1) != 0;
            const int nit = (N_ALL - b2 + nb - 1) / nb, kmid = KA_ITEMS < nit ? KA_ITEMS : nit;
            for (int k = kmid; k < nit; ++k) {
                const int it = b2 + (rev ? nit - 1 - k : k) * nb;
                if (it < N_PS) { if (args.sub & 4) swa_prompt_block(args, lds, btab, bucket, it, tid, lane, wave); }
                else if (it < N_PS + N_SS) { if (args.sub & 2) swa_sample_item(args, lds, bucket, it - N_PS, tid, lane, wave); }
                else { if (args.sub & 16) gdn_sample_item(args, lds, it - N_PS - N_SS, tid, lane, wave); }
            }
            if (args.sub & 64) gdn_out_phase(args, lds, b2, nb, 0, SPL, tid, lane, wave);
        }
    }
    SEAM(4);
    if (IN(5)) { gdn_out_phase(args, lds, bid, G, SPL, NCH, tid, lane, wave); }
    SEAM(5);
    if (IN(6)) {
        pg8::Gemm g{(const pg8::bf16_t*)(args.ws + WS_XN), (const pg8::bf16_t*)(args.ws + WS_WOUT), 64, DM / 256, DM};
        pg8::StaticOrder S; S.init(64, g.nN, G, bid, g.K / 64, 5, NSPLIT);
        EpiSplit E{(bf16*)(args.ws + WS_MIXOUT), DM, (float*)(args.ws + WS_PART), TAIL_ROW0, TAIL_ROWS};
        pg8::gemm_phase<EpiSplit, pg8::AMapStd>(lds, g, S, E);
    }
    SEAM(6);
    if (IN(7)) { p6_rows(args, gw, NGW, lane); }
    SEAM(7);
    if (IN(8)) {
        pg8::Gemm g{(const pg8::bf16_t*)(args.ws + WS_XN), (const pg8::bf16_t*)(args.ws + WS_WGU), FFN_NM, DFF / 128, DM};
        pg8::StaticOrder S; S.init(g.nM, g.nN, G, bid, g.K / 64);
        EpiFfn E{(bf16*)(args.ws + WS_ACT), args.in[22], args.in[6], args.out, (LAS float*)(lds + XCH_OFF)};
        pg8::gemm_phase<EpiFfn, AMapFfn>(lds, g, S, E);
    }
    SEAM(8);
    if (IN(9)) {
        pg8::Gemm g{(const pg8::bf16_t*)(args.ws + WS_ACT), (const pg8::bf16_t*)(args.ws + WS_WDOWN), 64, DM / 256, DFF};
        pg8::StaticOrder S; S.init(64, g.nN, G, bid, g.K / 64, 5, NSPLIT);
        EpiSplit E{(bf16*)(args.ws + WS_XN), DM, (float*)(args.ws + WS_PART), TAIL_ROW0, TAIL_ROWS};
        pg8::gemm_phase<EpiSplit, pg8::AMapStd>(lds, g, S, E);
    }
    SEAM(9);
    if (IN(10)) { p9_rows(args, lds, tid, gw, NGW, lane); }
#undef IN
#undef SEAM
}

extern "C" void kernel_launch(void* const* d_in, const int* in_sizes, int n_in, void* d_out, int out_size, void* d_ws, size_t ws_size, hipStream_t stream) {
    static int grid = 0;
    if (grid == 0) {
        if (n_in != 24 || (size_t)out_size != O_END || ws_size < WS_END) { fprintf(stderr, "kernel_launch: unexpected shapes (n_in %d, out %d, ws %zu)\n", n_in, out_size, ws_size); grid = -1; return; }
        int dev = 0, cus = 0;
        if (hipGetDevice(&dev) != hipSuccess || hipDeviceGetAttribute(&cus, hipDeviceAttributeMultiprocessorCount, dev) != hipSuccess) { grid = -1; return; }
        if (hipFuncSetAttribute((const void*)mega_fwd, hipFuncAttributeMaxDynamicSharedMemorySize, LDS_BYTES) != hipSuccess) { fprintf(stderr, "kernel_launch: hipFuncSetAttribute failed\n"); grid = -1; return; }
        (void)hipGetLastError();
        grid = cus;
    }
    if (grid < 0) return;
    if (hipMemsetAsync((char*)d_ws + WS_CTL, 0, CTL_ZERO_BYTES, stream) != hipSuccess) return;
    Args a{};
    for (int i = 0; i < 24; ++i) a.in[i] = (const float*)d_in[i];
    a.out = (float*)d_out; a.ws = (unsigned char*)d_ws; a.sub = 127;
#if MK_PER_PHASE
#ifndef REP_SUB
#define REP_SUB 63
#endif
#ifndef REP_N
#define REP_N 1
#endif
    for (int p = 0; p < N_PHASES; ++p) for (int rep = 0; rep < 1 + REP_N * ((REP_MASK >> p) & 1); ++rep) { a.ph_lo = p; a.ph_hi = p + 1; a.sub = rep ? REP_SUB : 127; hipLaunchKernelGGL(mega_fwd, dim3(grid), dim3(NTHR), LDS_BYTES, stream, a); }
#else
    a.ph_lo = 0; a.ph_hi = N_PHASES;
    hipLaunchKernelGGL(mega_fwd, dim3(grid), dim3(NTHR), LDS_BYTES, stream, a);
#endif
}
```
